# Optimizing an MI355X kernel written in HIP

```python
import jax, jax.numpy as jnp
from jax import lax
import numpy as np

D_MODEL = 2048
BATCH = 4
SEQ = 8192
DEPTH = 2
DEC_BATCH = 8
DEC_SEQ = 4096
PAST_LEN = 128

GRID_W = 64
POOL_WINDOWS = (2, 4, 8, 16)
POOL_GROUPS = len(POOL_WINDOWS)
D_POOL = D_MODEL // 2
POOL_GC = D_POOL // POOL_GROUPS
CHUNK = 128
SGU_GROUPS = 8
D_SGU = D_MODEL // 2
SGU_GC = D_SGU // SGU_GROUPS
NA_HEADS = 16
NA_HEAD_DIM = 64
D_NA = NA_HEADS * NA_HEAD_DIM
NA_KH_MAX = 8
NA_KW = 16
N_BRANCH = 3
D_FF = 4 * D_MODEL
D_IN = D_POOL + 2 * D_SGU + 3 * D_NA + N_BRANCH * D_MODEL
SPLITS = tuple(int(i) for i in np.cumsum([D_POOL, D_SGU, D_SGU, D_NA, D_NA, D_NA]))
DN_ALPHA = (2 * DEPTH) ** 0.25
DN_BETA = (8 * DEPTH) ** -0.25
LN_EPS = 1e-5

kernel_name = "hybrid_pool_sgu_natten_encoder"


def layer_norm(x, g, b):
    x32 = x.astype(jnp.float32)
    mu = jnp.mean(x32, axis=-1, keepdims=True)
    var = jnp.mean(jnp.square(x32 - mu), axis=-1, keepdims=True)
    y = (x32 - mu) * lax.rsqrt(var + LN_EPS)
    return (y * g.astype(jnp.float32) + b.astype(jnp.float32)).astype(x.dtype)


def pool_mixer(a, w_pool, s_pool):
    bsz, s, _ = a.shape
    a32 = a.astype(jnp.float32).reshape(bsz, s, POOL_GROUPS, POOL_GC)
    cs = jnp.concatenate([jnp.zeros((bsz, 1, POOL_GROUPS, POOL_GC), jnp.float32),
                          jnp.cumsum(a32, axis=1)], axis=1)
    t = np.arange(s)
    outs = []
    for gi, w in enumerate(POOL_WINDOWS):
        lo = np.clip(t - w // 2, 0, s)
        hi = np.clip(t + w // 2, 0, s)
        inv_cnt = (1.0 / (hi - lo)).astype(np.float32)[None, :, None]
        csg = cs[:, :, gi]
        outs.append((csg[:, hi] - csg[:, lo]) * inv_cnt - a32[:, :, gi])
    p = jnp.stack(outs, axis=2).astype(a.dtype)
    y = jnp.einsum('bsgc,gcd->bsgd', p, w_pool).reshape(bsz, s, D_POOL)
    return y * s_pool


def sgu_mixer(u, v, ln_g, ln_b, w_s, b_s):
    bsz, s, _ = u.shape
    u = jax.nn.gelu(u)
    v = layer_norm(jax.nn.gelu(v), ln_g, ln_b)
    vc = v.reshape(bsz, s // CHUNK, CHUNK, SGU_GROUPS, SGU_GC)
    sg = jnp.einsum('gpq,bnqgc->bnpgc', w_s, vc) + b_s.T[None, None, :, :, None]
    return u * sg.reshape(bsz, s, D_SGU)


def neighbourhood_attention(q, k, v, rpb):
    bsz, s, h, dh = q.shape
    rows = s // GRID_W
    kh = min(NA_KH_MAX, rows)
    qg = q.reshape(bsz, rows, GRID_W, h, dh)
    kg = k.reshape(bsz, rows, GRID_W, h, dh)
    vg = v.reshape(bsz, rows, GRID_W, h, dh)
    col = np.arange(GRID_W)
    c0 = np.clip(col - NA_KW // 2, 0, GRID_W - NA_KW)
    col_idx = c0[:, None] + np.arange(NA_KW)[None, :]
    dc = col_idx - col[:, None]
    scale = dh ** -0.5

    def one_row(r):
        r0 = jnp.clip(r - kh // 2, 0, rows - kh)
        q_r = lax.dynamic_index_in_dim(qg, r, axis=1, keepdims=False)
        k_band = lax.dynamic_slice_in_dim(kg, r0, kh, axis=1)
        v_band = lax.dynamic_slice_in_dim(vg, r0, kh, axis=1)
        k_sel = k_band[:, :, col_idx]
        v_sel = v_band[:, :, col_idx]
        dr = r0 + jnp.arange(kh) - r
        bias = rpb[:, dr[:, None, None] + (NA_KH_MAX - 1), dc[None] + (NA_KW - 1)]
        sc = jnp.einsum('bqhd,biqjhd->bhqij', q_r, k_sel).astype(jnp.float32) * scale
        sc = sc + bias.astype(jnp.float32).transpose(0, 2, 1, 3)[None]
        p = jax.nn.softmax(sc.reshape(bsz, h, GRID_W, kh * NA_KW), axis=-1)
        p = p.reshape(bsz, h, GRID_W, kh, NA_KW).astype(v.dtype)
        return jnp.einsum('bhqij,biqjhd->bqhd', p, v_sel)

    out = lax.map(one_row, jnp.arange(rows))
    return out.transpose(1, 0, 2, 3, 4).reshape(bsz, s, h * dh)


def mixing_sublayer(x, w_in, w_pool, s_pool, sgu_ln_g, sgu_ln_b, w_s, b_s, rpb,
                    w_br_pool, w_br_sgu, w_br_na, w_out):
    bsz, s, _ = x.shape
    z = x @ w_in
    a, u, v, q, k, vv, g = jnp.split(z, SPLITS, axis=-1)
    y_a = pool_mixer(a, w_pool, s_pool) @ w_br_pool
    y_b = sgu_mixer(u, v, sgu_ln_g, sgu_ln_b, w_s, b_s) @ w_br_sgu
    hd = (bsz, s, NA_HEADS, NA_HEAD_DIM)
    y_c = neighbourhood_attention(q.reshape(hd), k.reshape(hd), vv.reshape(hd), rpb) @ w_br_na
    gates = jax.nn.sigmoid(g.reshape(bsz, s, N_BRANCH, D_MODEL))
    merged = gates[:, :, 0] * y_a + gates[:, :, 1] * y_b + gates[:, :, 2] * y_c
    return merged @ w_out


def trunk(x, w_in, w_pool, s_pool, sgu_ln_g, sgu_ln_b, w_s, b_s, rpb,
          w_br_pool, w_br_sgu, w_br_na, w_out, ln1_g, ln1_b, w_up, w_down, ln2_g, ln2_b):
    for l in range(DEPTH):
        m = mixing_sublayer(x, w_in[l], w_pool[l], s_pool[l], sgu_ln_g[l], sgu_ln_b[l], w_s[l], b_s[l],
                            rpb[l], w_br_pool[l], w_br_sgu[l], w_br_na[l], w_out[l])
        x = layer_norm(DN_ALPHA * x + m, ln1_g[l], ln1_b[l])
        f = jnp.square(jax.nn.relu(x @ w_up[l])) @ w_down[l]
        x = layer_norm(DN_ALPHA * x + f, ln2_g[l], ln2_b[l])
    return x


def setup_inputs(seed: int = 0) -> dict:
    key = jax.random.key(seed)
    ks = jax.random.split(key, 24)
    f32 = jnp.float32
    nrm = lambda k, shape, sc: jax.random.normal(k, shape, f32) * sc
    L = DEPTH
    return {
        "x_prompt": nrm(ks[0], (BATCH, SEQ, D_MODEL), 1.0),
        "x_sample": nrm(ks[1], (DEC_BATCH, DEC_SEQ, D_MODEL), 1.0),
        "w_in": nrm(ks[2], (L, D_MODEL, D_IN), D_MODEL ** -0.5),
        "w_pool": nrm(ks[3], (L, POOL_GROUPS, POOL_GC, POOL_GC), POOL_GC ** -0.5),
        "s_pool": 1.0 + nrm(ks[4], (L, D_POOL), 0.1),
        "sgu_ln_g": 1.0 + nrm(ks[5], (L, D_SGU), 0.01),
        "sgu_ln_b": nrm(ks[6], (L, D_SGU), 0.01),
        "w_s": nrm(ks[7], (L, SGU_GROUPS, CHUNK, CHUNK), CHUNK ** -0.5),
        "b_s": 1.0 + nrm(ks[8], (L, SGU_GROUPS, CHUNK), 0.01),
        "rpb": nrm(ks[9], (L, NA_HEADS, 2 * NA_KH_MAX - 1, 2 * NA_KW - 1), 0.1),
        "w_br_pool": nrm(ks[10], (L, D_POOL, D_MODEL), DN_BETA * D_POOL ** -0.5),
        "w_br_sgu": nrm(ks[11], (L, D_SGU, D_MODEL), DN_BETA * D_SGU ** -0.5),
        "w_br_na": nrm(ks[12], (L, D_NA, D_MODEL), DN_BETA * D_NA ** -0.5),
        "w_out": nrm(ks[13], (L, D_MODEL, D_MODEL), DN_BETA * D_MODEL ** -0.5),
        "ln1_g": 1.0 + nrm(ks[14], (L, D_MODEL), 0.01),
        "ln1_b": nrm(ks[15], (L, D_MODEL), 0.01),
        "w_up": nrm(ks[16], (L, D_MODEL, D_FF), DN_BETA * D_MODEL ** -0.5),
        "w_down": nrm(ks[17], (L, D_FF, D_MODEL), DN_BETA * D_FF ** -0.5),
        "ln2_g": 1.0 + nrm(ks[18], (L, D_MODEL), 0.01),
        "ln2_b": nrm(ks[19], (L, D_MODEL), 0.01),
    }


def reference(x_prompt, x_sample, w_in, w_pool, s_pool, sgu_ln_g, sgu_ln_b, w_s, b_s, rpb,
              w_br_pool, w_br_sgu, w_br_na, w_out, ln1_g, ln1_b, w_up, w_down, ln2_g, ln2_b):
    y_prompt = trunk(x_prompt, w_in, w_pool, s_pool, sgu_ln_g, sgu_ln_b, w_s, b_s, rpb,
                     w_br_pool, w_br_sgu, w_br_na, w_out, ln1_g, ln1_b, w_up, w_down, ln2_g, ln2_b)
    y_sample = trunk(x_sample, w_in, w_pool, s_pool, sgu_ln_g, sgu_ln_b, w_s, b_s, rpb,
                     w_br_pool, w_br_sgu, w_br_na, w_out, ln1_g, ln1_b, w_up, w_down, ln2_g, ln2_b)
    return (y_prompt, y_sample)
```

```cpp
#include <hip/hip_runtime.h>
#include <cstdio>
#include <cstdint>

namespace pg8 {
#define PG8_LAS __attribute__((address_space(3)))
typedef unsigned short bf16_t;
typedef short bf16x8 __attribute__((ext_vector_type(8)));
typedef float f32x4 __attribute__((ext_vector_type(4)));
typedef float f32x2 __attribute__((ext_vector_type(2)));
typedef unsigned u32x4 __attribute__((ext_vector_type(4)));
typedef unsigned u32x2 __attribute__((ext_vector_type(2)));
constexpr int BM = 256, BK = 64, HALF = 128, HTB = HALF * BK * 2  , STAGE_BYTES = 8 * HTB, NXCD = 8, WGM = 8;

__host__ __device__ __forceinline__ int lds_byte(int r, int c) { const int st = (r >> 4) * 2 + (c >> 5), rr = r & 15, cc = c & 31, ob = rr * 64 + cc * 2; return st * 1024 + (ob ^ (((ob >> 9) & 1) << 5)); }
__host__ __device__ __forceinline__ void stage_rc(int b, int& R, int& C) { const int st = b / 1024, sb = b % 1024, swz = sb ^ (((sb >> 9) & 1) << 5); R = (st >> 1) * 16 + swz / 64; C = (st & 1) * 32 + (swz % 64) / 2; }
__host__ __device__ __forceinline__ int perm32(int rho) { const int n = rho >> 4, i = rho & 15; return 8 * (i >> 2) + 4 * n + (i & 3); }

struct Unit { int pm, pn, br; };
struct Gemm { const bf16_t* A; const bf16_t* Bt; int lda, ldb, K; size_t a_pn, a_br, b_br; };

struct StaticOrder {
    int nM, nN, nwg, G, c, wgm;
    __host__ __device__ void init(int M, int N, int G_, int c_, int wgm_ = WGM) { nM = M / BM; nN = N / BM; nwg = nM * nN; G = G_; c = c_; wgm = wgm_; }
    __host__ __device__ bool tile(long L, Unit& u) const {
        if (L >= nwg) return false;
        int wgid = (int)L; { const int q = nwg / NXCD, r = nwg % NXCD, xcd = wgid % NXCD, off = wgid / NXCD; wgid = (xcd < r ? xcd * (q + 1) : r * (q + 1) + (xcd - r) * q) + off; }
        const int nig = wgm * nN, gid = wgid / nig, fm = gid * wgm, gsz = (nM - fm) < wgm ? (nM - fm) : wgm;
        u.pm = fm + ((wgid % nig) % gsz); u.pn = (wgid % nig) / gsz; return true;
    }
    __host__ __device__ bool next(int i, Unit& u) const { u.br = 0; return tile((long)i * G + c, u); }
    __device__ __forceinline__ void a_ready(const Unit&) const {}
    __device__ __forceinline__ void done(const Unit&) const {}
};
struct TripleOrder : StaticOrder {
    __host__ __device__ bool next(int i, Unit& u) const { u.br = i % 3; return tile((long)(i / 3) * G + c, u); }
};

__device__ __forceinline__ unsigned cvt_pk_bf16(float lo, float hi) { unsigned r; asm volatile("v_cvt_pk_bf16_f32 %0, %1, %2" : "=v"(r) : "v"(lo), "v"(hi)); return r; }
__device__ __forceinline__ float bf_lo(unsigned w) { return __uint_as_float(w << 16); }
__device__ __forceinline__ float bf_hi(unsigned w) { return __uint_as_float(w & 0xffff0000u); }

template <class Epi, class Sched, bool ALIGN_EPI = false, bool SP2 = false>
__device__ __forceinline__ void gemm_phase(PG8_LAS unsigned char* lds, const Gemm g, const Sched& S, const Epi& E) {
    int tid = threadIdx.x; asm volatile("" : "+v"(tid));
    const int wid = __builtin_amdgcn_readfirstlane(tid >> 6), lane = tid & 63, wr = wid >> 2, wc = wid & 3, fr = lane & 15, fq = lane >> 4;
    const int K = g.K, nt = K / BK;
    unsigned voffA[2], voffB[2];
#pragma unroll
    for (int i = 0; i < 2; ++i) { int R, C; stage_rc(tid * 16 + i * 8192, R, C); const int Rb = Epi::PERM ? ((R & ~31) + perm32(R & 31)) : R;
        voffA[i] = (unsigned)(R * g.lda + C) * 2u; voffB[i] = (unsigned)(Rb * g.ldb + C) * 2u; }
    const size_t kstep = (size_t)(BK * 2);
    const size_t hstepA = (size_t)HALF * g.lda * 2, hstepB = (size_t)HALF * g.ldb * 2;
    const unsigned ldsw = (unsigned)wid * 1024u;
    const int aoff = lds_byte(wr * 64 + fr, fq * 8), boff = lds_byte(wc * 32 + fr, fq * 8);
#define PG8_SA(b, h) (((b) * 2 + (h)) * HTB)
#define PG8_SB(b, h) ((4 + (b) * 2 + (h)) * HTB)
#define PG8_STAGE(bufoff, gbase, voff) do { _Pragma("unroll") for (int _i = 0; _i < 2; ++_i) \
        __builtin_amdgcn_global_load_lds((const unsigned*)((const char*)(gbase) + (voff)[_i]), (PG8_LAS unsigned*)(lds + (bufoff) + ldsw + _i * 8192), 16, 0, 0); } while (0)
#define PG8_LDA(dst, b, h) do { _Pragma("unroll") for (int m = 0; m < 4; ++m) _Pragma("unroll") for (int k = 0; k < 2; ++k) dst[m][k] = *(const PG8_LAS bf16x8*)(lds + PG8_SA(b, h) + aoff + m * 2048 + k * 1024); } while (0)
#define PG8_LDB(dst, b, h) do { _Pragma("unroll") for (int n = 0; n < 2; ++n) _Pragma("unroll") for (int k = 0; k < 2; ++k) dst[n][k] = *(const PG8_LAS bf16x8*)(lds + PG8_SB(b, h) + boff + n * 2048 + k * 1024); } while (0)
#define PG8_MMA(ai, bj, At, Bt) do { __builtin_amdgcn_s_setprio(1); _Pragma("unroll") for (int m = 0; m < 4; ++m) _Pragma("unroll") for (int n = 0; n < 2; ++n) _Pragma("unroll") for (int k = 0; k < 2; ++k) \
        acc[ai][bj][m][n] = __builtin_amdgcn_mfma_f32_16x16x32_bf16(Bt[n][k], At[m][k], acc[ai][bj][m][n], 0, 0, 0); __builtin_amdgcn_s_setprio(0); } while (0)
#define PG8_WAIT_V(n) asm volatile("s_waitcnt vmcnt(" #n ")" ::: "memory")
#define PG8_WAIT_L(n) asm volatile("s_waitcnt lgkmcnt(" #n ")" ::: "memory")
#define PG8_BAR __builtin_amdgcn_s_barrier()
#define PG8_SCHED __builtin_amdgcn_sched_barrier(0)
#define PG8_UA(u) ((const char*)g.A + (size_t)(u).pm * 2 * hstepA + (size_t)(u).pn * g.a_pn + (size_t)(u).br * g.a_br)
#define PG8_UB(u) ((const char*)g.Bt + (size_t)(u).pn * 2 * hstepB + (size_t)(u).br * g.b_br)
    Unit cur, nxt; int ui = 0;
    if (!S.next(0, cur)) return;
    f32x4 acc[2][2][4][2];
#pragma unroll
    for (int a = 0; a < 2; ++a)
#pragma unroll
        for (int b = 0; b < 2; ++b)
#pragma unroll
            for (int m = 0; m < 4; ++m)
#pragma unroll
                for (int n = 0; n < 2; ++n) acc[a][b][m][n] = (f32x4){0.f, 0.f, 0.f, 0.f};
    bf16x8 At[4][2], B0[2][2], B1[2][2];
    const char* cA = PG8_UA(cur); const char* cB = PG8_UB(cur);
    S.a_ready(cur);
    if constexpr (SP2) {
        PG8_STAGE(PG8_SB(0, 0), cB, voffB); PG8_STAGE(PG8_SB(0, 1), cB + hstepB, voffB); PG8_STAGE(PG8_SA(0, 0), cA, voffA); PG8_STAGE(PG8_SA(0, 1), cA + hstepA, voffA);
        if (wr == 1) PG8_BAR;
        PG8_WAIT_V(2); PG8_BAR;
        PG8_STAGE(PG8_SB(1, 0), cB + kstep, voffB); PG8_STAGE(PG8_SA(1, 0), cA + kstep, voffA); PG8_STAGE(PG8_SB(1, 1), cB + hstepB + kstep, voffB);
        PG8_WAIT_V(6); PG8_BAR;
    } else {
        PG8_STAGE(PG8_SB(0, 0), cB, voffB); PG8_STAGE(PG8_SA(0, 0), cA, voffA); PG8_STAGE(PG8_SB(0, 1), cB + hstepB, voffB); PG8_STAGE(PG8_SA(0, 1), cA + hstepA, voffA);
        if (wr == 1) PG8_BAR;
        PG8_WAIT_V(4); PG8_BAR;
        PG8_STAGE(PG8_SB(1, 0), cB + kstep, voffB); PG8_STAGE(PG8_SA(1, 0), cA + kstep, voffA); PG8_STAGE(PG8_SB(1, 1), cB + hstepB + kstep, voffB);
        PG8_WAIT_V(6); PG8_BAR;
    }
    for (;;) {
        const bool has_next = S.next(ui + 1, nxt);
        const char* nA = has_next ? PG8_UA(nxt) : cA; const char* nB = has_next ? PG8_UB(nxt) : cB;
#pragma unroll 1
        for (int t = 0; t < nt; t += 2) {
            const bool last = (t == nt - 2);
            const char* a1 = cA + (size_t)(t + 1) * kstep;
            const char* a2 = last ? nA : cA + (size_t)(t + 2) * kstep; const char* b2 = last ? nB : cB + (size_t)(t + 2) * kstep;
            const char* a3 = a2 + kstep; const char* b3 = b2 + kstep;
            if (last && has_next) S.a_ready(nxt);
            if constexpr (SP2) {
            PG8_LDB(B0, 0, 0); PG8_LDB(B1, 0, 1); PG8_SCHED; PG8_LDA(At, 0, 0); PG8_STAGE(PG8_SA(1, 1), a1 + hstepA, voffA);
            PG8_WAIT_V(8); PG8_WAIT_L(0); PG8_BAR; PG8_MMA(0, 0, At, B0); PG8_MMA(0, 1, At, B1); PG8_BAR; PG8_SCHED;
            PG8_LDA(At, 0, 1); PG8_STAGE(PG8_SB(0, 0), b2, voffB); PG8_STAGE(PG8_SB(0, 1), b2 + hstepB, voffB); PG8_STAGE(PG8_SA(0, 0), a2, voffA);
            PG8_WAIT_V(8); PG8_WAIT_L(0); PG8_BAR; PG8_MMA(1, 0, At, B0); PG8_MMA(1, 1, At, B1); PG8_BAR; PG8_SCHED;
            PG8_LDB(B0, 1, 0); PG8_LDB(B1, 1, 1); PG8_SCHED; PG8_LDA(At, 1, 0); PG8_STAGE(PG8_SA(0, 1), a2 + hstepA, voffA);
            PG8_WAIT_V(8); PG8_WAIT_L(0); PG8_BAR; PG8_MMA(0, 0, At, B0); PG8_MMA(0, 1, At, B1); PG8_BAR; PG8_SCHED;
            PG8_LDA(At, 1, 1); PG8_STAGE(PG8_SB(1, 0), b3, voffB); PG8_STAGE(PG8_SB(1, 1), b3 + hstepB, voffB); PG8_STAGE(PG8_SA(1, 0), a3, voffA);
            PG8_WAIT_V(8); PG8_WAIT_L(0); PG8_BAR; PG8_MMA(1, 0, At, B0); PG8_MMA(1, 1, At, B1); PG8_BAR; PG8_SCHED;
            } else {
            PG8_LDB(B0, 0, 0); PG8_SCHED; PG8_LDA(At, 0, 0); PG8_STAGE(PG8_SA(1, 1), a1 + hstepA, voffA);
            PG8_WAIT_L(8); PG8_BAR; PG8_WAIT_L(0); PG8_MMA(0, 0, At, B0); PG8_BAR; PG8_SCHED;
            PG8_LDB(B1, 0, 1); PG8_STAGE(PG8_SB(0, 0), b2, voffB);
            PG8_BAR; PG8_WAIT_L(0); PG8_MMA(0, 1, At, B1); PG8_BAR;
            PG8_LDA(At, 0, 1); PG8_STAGE(PG8_SA(0, 0), a2, voffA);
            PG8_BAR; PG8_WAIT_L(0); PG8_MMA(1, 0, At, B0); PG8_BAR; PG8_SCHED;
            PG8_STAGE(PG8_SB(0, 1), b2 + hstepB, voffB);
            PG8_WAIT_V(6); PG8_BAR; PG8_MMA(1, 1, At, B1); PG8_BAR;
            PG8_LDB(B0, 1, 0); PG8_SCHED; PG8_LDA(At, 1, 0); PG8_STAGE(PG8_SA(0, 1), a2 + hstepA, voffA);
            PG8_WAIT_L(8); PG8_BAR; PG8_WAIT_L(0); PG8_MMA(0, 0, At, B0); PG8_BAR; PG8_SCHED;
            PG8_LDB(B1, 1, 1); PG8_STAGE(PG8_SB(1, 0), b3, voffB);
            PG8_BAR; PG8_WAIT_L(0); PG8_MMA(0, 1, At, B1); PG8_BAR;
            PG8_LDA(At, 1, 1); PG8_STAGE(PG8_SA(1, 0), a3, voffA);
            PG8_BAR; PG8_WAIT_L(0); PG8_MMA(1, 0, At, B0); PG8_BAR; PG8_SCHED;
            PG8_STAGE(PG8_SB(1, 1), b3 + hstepB, voffB);
            PG8_WAIT_V(6); PG8_BAR; PG8_MMA(1, 1, At, B1); PG8_BAR;
            }
        }
        if constexpr (ALIGN_EPI) { if (wr == 0) PG8_BAR; }
        E(acc, cur, wr, wc, fr, fq); S.done(cur);
        if (!has_next) break;
        if (!(Epi::CHAIN && cur.br < 2)) {
#pragma unroll
        for (int a = 0; a < 2; ++a)
#pragma unroll
            for (int b = 0; b < 2; ++b)
#pragma unroll
                for (int m = 0; m < 4; ++m)
#pragma unroll
                    for (int n = 0; n < 2; ++n) acc[a][b][m][n] = (f32x4){0.f, 0.f, 0.f, 0.f};
        }
        cur = nxt; cA = nA; cB = nB; ++ui;
        if constexpr (ALIGN_EPI) { if (wr == 1) PG8_BAR; }
    }
    PG8_WAIT_V(0);
    if constexpr (!ALIGN_EPI) { if (wr == 0) PG8_BAR; }
    PG8_BAR;
#undef PG8_UA
#undef PG8_UB
#undef PG8_SA
#undef PG8_SB
#undef PG8_STAGE
#undef PG8_LDA
#undef PG8_LDB
#undef PG8_MMA
#undef PG8_WAIT_V
#undef PG8_WAIT_L
#undef PG8_BAR
#undef PG8_SCHED
}
}
#define PG8_SP2 true
#define PG8_ALIGN true

constexpr int DM = 2048, DIN = 12288, DFF = 8192, DEPTH = 2;
constexpr int NTOK = 65536, CH = 16384, NCHUNK = NTOK / CH;
constexpr int SEQ_P = 8192, SEQ_S = 4096, PROMPT_ROWS = 32768;
constexpr int GRID_W = 64, NA_HEADS = 16, NA_KH = 8, NA_KW = 16;
constexpr float LN_EPS = 1e-5f;
constexpr float DN_ALPHA = 1.4142135623730951f;

constexpr size_t MiB = 1u << 20;
constexpr size_t WS_CTL = 0, CTL_ZERO_BYTES = 1 * MiB;
constexpr size_t WS_WIN = 1 * MiB;
constexpr size_t WS_WBR = 97 * MiB;
constexpr size_t WS_WOUT = 121 * MiB;
constexpr size_t WS_WUP = 137 * MiB;
constexpr size_t WS_WDN = 201 * MiB;
constexpr size_t WS_WPOOL = 265 * MiB;
constexpr size_t WS_WSB = 266 * MiB;
constexpr size_t WS_XB = 267 * MiB;
constexpr size_t WS_Z6 = 331 * MiB;
constexpr size_t WS_G = 523 * MiB;
constexpr size_t WS_H = 331 * MiB;
constexpr size_t WS_M32 = 331 * MiB;
constexpr size_t WS_MERGED = 395 * MiB;
constexpr size_t WS_PP = 715 * MiB;
constexpr size_t WS_P3 = 747 * MiB;
constexpr size_t WS_STATS = 843 * MiB;
constexpr size_t WS_NATB = 844 * MiB;
constexpr size_t WS_RF = 619 * MiB;
constexpr size_t WS_END = 846 * MiB;
static_assert(WS_G + (size_t)(CH / 256) * 24 * 65536 <= WS_RF && WS_RF + (size_t)CH * DM * 4 <= WS_P3 && WS_H + (size_t)CH * DFF * 2 <= WS_RF, "workspace map: the 8-bit gates end below the fragment-order residual, which ends below the mixer outputs; h stays below it too");
constexpr size_t CS_OFF = 262144; constexpr int CS_WIN_G = 0, CS_WIN_B = DIN, CS_WUP_G = 2 * DIN, CS_WUP_B = 2 * DIN + 2 * DFF;
constexpr size_t ZSTRIDE = (size_t)CH * 1024;
constexpr int CW_BAR = 4096;

constexpr int RING_OFF = 0, RING_BYTES = 131072;
constexpr int NA_KPITCH = 144, NA_RPITCH = 64 * NA_KPITCH + 16, NA_BAND = 8 * NA_RPITCH;
constexpr int STATS_OFF = 148480;
constexpr int MISC_OFF = STATS_OFF + 2048;
constexpr int LDS_BYTES = 151552;
static_assert(2 * NA_BAND <= STATS_OFF && RING_BYTES <= STATS_OFF, "LDS map");

#define GAS __attribute__((address_space(1)))
#define LAS __attribute__((address_space(3)))
typedef unsigned short bf16;
typedef unsigned v4u __attribute__((ext_vector_type(4)));
typedef unsigned v2u __attribute__((ext_vector_type(2)));
typedef float f32x4 __attribute__((ext_vector_type(4)));
typedef GAS unsigned gu32;
#define RLX_AGENT __ATOMIC_RELAXED, __HIP_MEMORY_SCOPE_AGENT
#define LDS_WAIT() asm volatile("s_waitcnt lgkmcnt(0)" ::: "memory")
__device__ __forceinline__ unsigned f2bf(float f) { unsigned u = __builtin_bit_cast(unsigned, f); return (u + 0x7fffu + ((u >> 16) & 1u)) >> 16; }
__device__ __forceinline__ unsigned pk2(float lo, float hi) { return f2bf(lo) | (f2bf(hi) << 16); }
__device__ __forceinline__ float bflo(unsigned w) { return __uint_as_float(w << 16); }
__device__ __forceinline__ float bfhi(unsigned w) { return __uint_as_float(w & 0xffff0000u); }

#define XB_TMO      128
#define XB_XCNT(j)  (256  + 64 * (j))
#define XB_XSUB(j)  (1280 + 64 * (j))
#define XB_XGEN(j)  (2304 + 64 * (j))
#define XB_TOP      3328
#define XB_TOPGEN   3392
#define XCD_BAR_WORDS 3456
#define XB_SPIN_CAP (1u << 18)

__device__ __forceinline__ unsigned xb_ld(unsigned* p)              { return __hip_atomic_load(p, __ATOMIC_RELAXED, __HIP_MEMORY_SCOPE_AGENT); }
__device__ __forceinline__ unsigned xb_add(unsigned* p, unsigned v) { return __hip_atomic_fetch_add(p, v, __ATOMIC_RELAXED, __HIP_MEMORY_SCOPE_AGENT); }
__device__ __forceinline__ unsigned xb_xcc_id() { return (unsigned)__builtin_amdgcn_s_getreg((3 << 11) | 20) & 0xFu; }
#define XB_SPIN(cond, bar) do { unsigned _sp = 0; while (cond) { __builtin_amdgcn_s_sleep(1); \
    if ((++_sp & 255u) == 0u) { if (xb_ld(&(bar)[XB_TMO])) break; if (_sp > XB_SPIN_CAP) { atomicAdd(&(bar)[XB_TMO], 1u); break; } } } } while (0)

struct XcdBarrier {
    unsigned* bar; unsigned x;
    volatile LAS unsigned* st;
};
__device__ __forceinline__ XcdBarrier xcd_barrier_post(unsigned* bar, volatile LAS unsigned* st) {
    XcdBarrier b; b.bar = bar; b.x = (unsigned)__builtin_amdgcn_readfirstlane((int)xb_xcc_id()); b.st = st;
    if (threadIdx.x == 0) (void)xb_add(&bar[XB_XCNT(b.x)], 1u);
    return b;
}
__device__ __forceinline__ void xcd_barrier_complete(unsigned* bar, unsigned x, unsigned& nloc, unsigned& nx) {
    const unsigned G = gridDim.x * gridDim.y * gridDim.z;
    unsigned sum, cnt, mine, sp = 0u;
    for (;;) {
        sum = 0u; cnt = 0u; mine = 0u;
#pragma unroll
        for (unsigned j = 0; j < 16; ++j) { const unsigned c = xb_ld(&bar[XB_XCNT(j)]); sum += c; cnt += (c > 0u) ? 1u : 0u; mine = (j == x) ? c : mine; }
        if (sum == G) break;
        __builtin_amdgcn_s_sleep(1);
        if ((++sp & 255u) == 0u) { if (xb_ld(&bar[XB_TMO])) break; if (sp > XB_SPIN_CAP) { atomicAdd(&bar[XB_TMO], 1u); break; } }
    }
    nloc = mine > 0u ? mine : 1u; nx = cnt > 0u ? cnt : 1u;
}
__device__ __forceinline__ void xcd_barrier(const XcdBarrier& b) {
    asm volatile("s_waitcnt vmcnt(0)" ::: "memory");
    __syncthreads();
    if (threadIdx.x == 0) {
        unsigned* bar = b.bar; unsigned bxcc = b.x;
        asm volatile("" : "+s"(bar), "+s"(bxcc));
        __builtin_amdgcn_s_waitcnt(0);
        unsigned nloc = b.st[0], nx = b.st[1];
        if (nloc == 0u) { xcd_barrier_complete(bar, bxcc, nloc, nx); b.st[0] = nloc; b.st[1] = nx; }
        const unsigned old = xb_add(&bar[XB_XSUB(bxcc)], 1u);
        const unsigned gen = old / nloc;
        if (old + 1u == (gen + 1u) * nloc) {
            __builtin_amdgcn_fence(__ATOMIC_RELEASE, "agent");
            asm volatile("s_waitcnt vmcnt(0)" ::: "memory");
            const unsigned og = xb_add(&bar[XB_TOP], 1u);
            const unsigned tg = og / nx;
            if (og + 1u == (tg + 1u) * nx) xb_add(&bar[XB_TOPGEN], 1u);
            else XB_SPIN(xb_ld(&bar[XB_TOPGEN]) == tg, bar);
            __builtin_amdgcn_fence(__ATOMIC_ACQUIRE, "agent");
            xb_add(&bar[XB_XGEN(bxcc)], 1u);
            asm volatile("s_waitcnt vmcnt(0)" ::: "memory");
        } else {
            XB_SPIN(xb_ld(&bar[XB_XGEN(bxcc)]) == gen, bar);
            __builtin_amdgcn_fence(__ATOMIC_ACQUIRE, "agent");
            asm volatile("s_waitcnt vmcnt(0)" ::: "memory");
        }
    }
    __syncthreads();
}

__device__ __forceinline__ float wave_sum(float v) {
#pragma unroll
    for (int o = 1; o < 64; o <<= 1) v += __shfl_xor(v, o);
    return v;
}

namespace pg8 {
#define PG8_ROWOFF(ai, m) ({ int _ro = (ai) * HALF + (m) * 16; asm volatile("" : "+s"(_ro)); _ro; })
#define PG8_PAIR_FENCE(m) do { if ((m) & 1) asm volatile("" ::: "memory"); } while (0)
__device__ __forceinline__ float sigmoidf_fast(float x) { return __builtin_amdgcn_rcpf(1.0f + __builtin_amdgcn_exp2f(-1.4426950408889634f * x)); }
__device__ __forceinline__ u32x4 pack8(const f32x4& v0, const f32x4& v1) { u32x4 w; w.x = cvt_pk_bf16(v0[0], v0[1]); w.y = cvt_pk_bf16(v0[2], v0[3]); w.z = cvt_pk_bf16(v1[0], v1[1]); w.w = cvt_pk_bf16(v1[2], v1[3]); return w; }
__device__ __forceinline__ unsigned q8x4(const f32x4& v) { unsigned r = 0u;
    r = __builtin_amdgcn_cvt_pk_u8_f32(__builtin_floorf(v[0] * 255.f + 0.5f), 0, r); r = __builtin_amdgcn_cvt_pk_u8_f32(__builtin_floorf(v[1] * 255.f + 0.5f), 1, r);
    r = __builtin_amdgcn_cvt_pk_u8_f32(__builtin_floorf(v[2] * 255.f + 0.5f), 2, r); r = __builtin_amdgcn_cvt_pk_u8_f32(__builtin_floorf(v[3] * 255.f + 0.5f), 3, r); return r; }
__device__ __forceinline__ f32x4 u8x4_f32(unsigned w) { return (f32x4){(float)(w & 0xffu), (float)((w >> 8) & 0xffu), (float)((w >> 16) & 0xffu), (float)(w >> 24)}; }
__device__ __forceinline__ void row_stats(const float* st, int row, float& mu, float& rs) { const f32x2 sv = *(const f32x2*)(st + 2 * (size_t)row); mu = sv.x * (1.f / DM); rs = rsqrtf(fmaxf(sv.y * (1.f / DM) - mu * mu, 0.f) + LN_EPS); }
struct LnFold {
    const float* st; const float* gw; const float* bw;
    struct Regs { float mu[8], rs[8]; f32x4 g[2][2], b[2][2]; };
    __device__ __forceinline__ void load(Regs& R, int row0, int gcol0) const {
        if (st) {
#pragma unroll
            for (int k = 0; k < 8; ++k) row_stats(st, row0 + (k >> 2) * HALF + (k & 3) * 16, R.mu[k], R.rs[k]);
#pragma unroll
            for (int bj = 0; bj < 2; ++bj)
#pragma unroll
                for (int n = 0; n < 2; ++n) { R.g[bj][n] = *(const f32x4*)(gw + gcol0 + bj * HALF + 4 * n); R.b[bj][n] = *(const f32x4*)(bw + gcol0 + bj * HALF + 4 * n); }
        }
    }
    __device__ __forceinline__ void apply(const Regs& R, f32x4& v0, f32x4& v1, int k, int bj) const {
        if (st) { v0 = (v0 - R.g[bj][0] * R.mu[k]) * R.rs[k] + R.b[bj][0]; v1 = (v1 - R.g[bj][1] * R.mu[k]) * R.rs[k] + R.b[bj][1]; } }
};
struct EpiZ {
    static constexpr bool PERM = true; static constexpr bool CHAIN = false;
    bf16_t* Z6; bf16_t* G; LnFold F;
    __device__ __forceinline__ void operator()(const f32x4 (&acc)[2][2][4][2], const Unit& u, int wr, int wc, int fr, int fq) const {
        bf16_t* base; int ldc, colt, act; float sc = 1.f;
        const int row0 = u.pm * BM + wr * 64 + fr, gcol0 = u.pn * BM + wc * 32 + 8 * fq;
        if (u.pn < 24) { const int t = u.pn >> 2; base = Z6 + (size_t)t * ZSTRIDE; ldc = 1024; colt = (u.pn & 3) * BM; act = (t == 1 || t == 2) ? 1 : 0; if (t == 3) sc = 0.125f; }
        else { base = G; ldc = 6144; colt = (u.pn - 24) * BM; act = 2; }
        bf16_t* const p0 = base + (size_t)row0 * ldc + colt + wc * 32 + 8 * fq;
        unsigned char* const gfrag = (unsigned char*)G + ((size_t)(u.pm * 24 + (u.pn - 24)) * 16 * 512 + ((((wr * 4 + wc) << 6) | (fq << 4) | fr))) * 8;
        LnFold::Regs R; F.load(R, row0, gcol0);
#pragma unroll
        for (int ai = 0; ai < 2; ++ai)
#pragma unroll
            for (int m = 0; m < 4; ++m) { const int ro = PG8_ROWOFF(ai, m); bf16_t* rowp = p0 + (size_t)ro * ldc;
#pragma unroll
                for (int bj = 0; bj < 2; ++bj) { f32x4 v0 = acc[ai][bj][m][0], v1 = acc[ai][bj][m][1];
                    F.apply(R, v0, v1, ai * 4 + m, bj);
                    if (act != 0) {
#pragma unroll
                        for (int j = 0; j < 4; ++j) { const float x = v0[j], y = v1[j];
                            const float sx = (act == 1) ? 1.5957691216057308f * (x + 0.044715f * x * x * x) : x, sy = (act == 1) ? 1.5957691216057308f * (y + 0.044715f * y * y * y) : y;
                            const float gx = sigmoidf_fast(sx), gy = sigmoidf_fast(sy); v0[j] = (act == 1) ? x * gx : gx; v1[j] = (act == 1) ? y * gy : gy; } }
                    if (act == 2) *(u32x2*)(gfrag + ((size_t)(((ro >> 3) - (ro >> 7) * 8 + bj) * 512)) * 8) = (u32x2){q8x4(v0), q8x4(v1)};
                    else *(u32x4*)(rowp + bj * HALF) = pack8(v0 * sc, v1 * sc); }
                PG8_PAIR_FENCE(m); }
    }
};
struct EpiPool {
    static constexpr bool PERM = true; static constexpr bool CHAIN = false;
    bf16_t* O; const float* sp;
    __device__ __forceinline__ void operator()(const f32x4 (&acc)[2][2][4][2], const Unit& u, int wr, int wc, int fr, int fq) const {
        const int col0 = u.pn * BM + wc * 32 + 8 * fq;
        bf16_t* const p0 = O + (size_t)(u.pm * BM + wr * 64 + fr) * 1024 + col0;
        f32x4 sv[2][2];
#pragma unroll
        for (int bj = 0; bj < 2; ++bj)
#pragma unroll
            for (int n = 0; n < 2; ++n) sv[bj][n] = *(const f32x4*)(sp + col0 + bj * HALF + 4 * n);
#pragma unroll
        for (int ai = 0; ai < 2; ++ai)
#pragma unroll
            for (int m = 0; m < 4; ++m) { bf16_t* rowp = p0 + (size_t)PG8_ROWOFF(ai, m) * 1024;
#pragma unroll
                for (int bj = 0; bj < 2; ++bj) *(u32x4*)(rowp + bj * HALF) = pack8(acc[ai][bj][m][0] * sv[bj][0], acc[ai][bj][m][1] * sv[bj][1]);
                PG8_PAIR_FENCE(m); }
    }
};
struct EpiGate {
    static constexpr bool PERM = true; static constexpr bool CHAIN = true;
    const bf16_t* G; bf16_t* MG;
    static __device__ __forceinline__ f32x4 floor4(f32x4 v) { return (f32x4){fmaxf(v[0], 1.0e-18f), fmaxf(v[1], 1.0e-18f), fmaxf(v[2], 1.0e-18f), fmaxf(v[3], 1.0e-18f)}; }
    static __device__ __forceinline__ f32x4 rcp4(f32x4 v) { return (f32x4){__builtin_amdgcn_rcpf(v[0]), __builtin_amdgcn_rcpf(v[1]), __builtin_amdgcn_rcpf(v[2]), __builtin_amdgcn_rcpf(v[3])}; }
    __device__ __forceinline__ void operator()(f32x4 (&acc)[2][2][4][2], const Unit& u, int wr, int wc, int fr, int fq) const {
        const int col0 = u.pn * BM + wc * 32 + 8 * fq; const size_t row0 = (size_t)(u.pm * BM + wr * 64 + fr);
        bf16_t* const m0 = MG + row0 * 2048 + col0;
        const unsigned char* const g0 = (const unsigned char*)G + ((size_t)(u.pm * 24 + u.br * 8 + u.pn) * 16 * 512 + ((((wr * 4 + wc) << 6) | (fq << 4) | fr))) * 8;
#pragma unroll
        for (int ai = 0; ai < 2; ++ai) {
            int ro[4]; u32x2 ga[4][2], gb[4][2];
#pragma unroll
            for (int m = 0; m < 4; ++m) { ro[m] = PG8_ROWOFF(ai, m);
#pragma unroll
                for (int bj = 0; bj < 2; ++bj) { const size_t so = (size_t)(((ro[m] >> 3) - (ro[m] >> 7) * 8 + bj) * 512) * 8;
                    ga[m][bj] = *(const u32x2*)(g0 + so);
                    if (u.br < 2) gb[m][bj] = *(const u32x2*)(g0 + so + (size_t)8 * 16 * 512 * 8); } }
#pragma unroll
            for (int m = 0; m < 4; ++m)
#pragma unroll
                for (int bj = 0; bj < 2; ++bj) {
                    f32x4 a0 = u8x4_f32(ga[m][bj].x), a1 = u8x4_f32(ga[m][bj].y);
                    if (u.br > 0) { a0 = floor4(a0); a1 = floor4(a1); }
                    if (u.br < 2) { const f32x4 b0 = floor4(u8x4_f32(gb[m][bj].x)), b1 = floor4(u8x4_f32(gb[m][bj].y));
                        acc[ai][bj][m][0] = acc[ai][bj][m][0] * (a0 * rcp4(b0)); acc[ai][bj][m][1] = acc[ai][bj][m][1] * (a1 * rcp4(b1)); }
                    else *(u32x4*)(m0 + (size_t)ro[m] * 2048 + bj * HALF) = pack8(acc[ai][bj][m][0] * (a0 * (1.f / 255.f)), acc[ai][bj][m][1] * (a1 * (1.f / 255.f))); }
            asm volatile("" ::: "memory"); }
    }
};
struct EpiResLn {
    static constexpr bool PERM = true; static constexpr bool CHAIN = false;
    const float* in32; float* out32; float* rf; bf16_t* rb; const float* st_in; const float* g_in; const float* b_in; float* st_out;
    __device__ __forceinline__ void operator()(const f32x4 (&acc)[2][2][4][2], const Unit& u, int wr, int wc, int fr, int fq) const {
        const int row0 = u.pm * BM + wr * 64 + fr, col0 = u.pn * BM + wc * 32 + 8 * fq;
        const size_t off0 = (size_t)row0 * 2048 + col0;
        float* const f0 = rf + (size_t)(u.pm * 8 + u.pn) * 65536 + (size_t)((((wr * 4 + wc) << 6) | (fq << 4) | fr)) * 4;
        f32x4 gv[2][2], bv[2][2];
        if (st_in) {
#pragma unroll
            for (int bj = 0; bj < 2; ++bj)
#pragma unroll
                for (int n = 0; n < 2; ++n) { gv[bj][n] = *(const f32x4*)(g_in + col0 + bj * HALF + 4 * n); bv[bj][n] = *(const f32x4*)(b_in + col0 + bj * HALF + 4 * n); }
        }
#define PG8_RES_BATCH(AI, M0, NB) do { int ro[NB]; f32x4 r[NB][2][2]; f32x2 sv[NB]; \
            _Pragma("unroll") for (int mm = 0; mm < NB; ++mm) { ro[mm] = PG8_ROWOFF(AI, (M0) + mm); \
                if (st_in) sv[mm] = *(const f32x2*)(st_in + 2 * (size_t)(row0 + ro[mm])); \
                _Pragma("unroll") for (int bj = 0; bj < 2; ++bj) _Pragma("unroll") for (int n = 0; n < 2; ++n) \
                    r[mm][bj][n] = in32 ? *(const f32x4*)(in32 + off0 + (size_t)ro[mm] * 2048 + bj * HALF + 4 * n) \
                                        : *(const f32x4*)(f0 + (size_t)((((ro[mm] >> 3) - (ro[mm] >> 7) * 8) * 2 + bj * 2 + n) * 2048)); } \
            _Pragma("unroll") for (int mm = 0; mm < NB; ++mm) { const int m = (M0) + mm; float ps = 0.f, pq = 0.f, mu = 0.f, rs = 1.f; \
                if (st_in) { mu = sv[mm].x * (1.f / DM); rs = rsqrtf(fmaxf(sv[mm].y * (1.f / DM) - mu * mu, 0.f) + LN_EPS); } \
                _Pragma("unroll") for (int bj = 0; bj < 2; ++bj) { f32x4 o[2]; \
                    _Pragma("unroll") for (int n = 0; n < 2; ++n) { f32x4 x = r[mm][bj][n]; \
                        if (st_in) x = (x - mu) * rs * gv[bj][n] + bv[bj][n]; \
                        o[n] = x * DN_ALPHA + acc[AI][bj][m][n]; \
                        if (out32) *(f32x4*)(out32 + off0 + (size_t)ro[mm] * 2048 + bj * HALF + 4 * n) = o[n]; \
                        else *(f32x4*)(f0 + (size_t)((((ro[mm] >> 3) - (ro[mm] >> 7) * 8) * 2 + bj * 2 + n) * 2048)) = o[n]; \
                        ps += (o[n][0] + o[n][1]) + (o[n][2] + o[n][3]); pq += (o[n][0] * o[n][0] + o[n][1] * o[n][1]) + (o[n][2] * o[n][2] + o[n][3] * o[n][3]); } \
                    if (rb) *(u32x4*)(rb + off0 + (size_t)ro[mm] * 2048 + bj * HALF) = pack8(o[0], o[1]); } \
                if (st_out) { ps += __shfl_xor(ps, 16); ps += __shfl_xor(ps, 32); pq += __shfl_xor(pq, 16); pq += __shfl_xor(pq, 32); \
                    if (fq == 0) { float* sp = st_out + 2 * (size_t)(row0 + ro[mm]); __hip_atomic_fetch_add(sp, ps, __ATOMIC_RELAXED, __HIP_MEMORY_SCOPE_AGENT); __hip_atomic_fetch_add(sp + 1, pq, __ATOMIC_RELAXED, __HIP_MEMORY_SCOPE_AGENT); } } } \
            asm volatile("" ::: "memory"); } while (0)
        PG8_RES_BATCH(0, 0, 1); PG8_RES_BATCH(0, 1, 1); PG8_RES_BATCH(0, 2, 2); PG8_RES_BATCH(1, 0, 2); PG8_RES_BATCH(1, 2, 2);
#undef PG8_RES_BATCH
    }
};
struct EpiSq {
    static constexpr bool PERM = true; static constexpr bool CHAIN = false;
    bf16_t* O; LnFold F;
    __device__ __forceinline__ void operator()(const f32x4 (&acc)[2][2][4][2], const Unit& u, int wr, int wc, int fr, int fq) const {
        const int row0 = u.pm * BM + wr * 64 + fr, gcol0 = u.pn * BM + wc * 32 + 8 * fq;
        bf16_t* const p0 = O + (size_t)row0 * DFF + gcol0;
        LnFold::Regs R; F.load(R, row0, gcol0);
#pragma unroll
        for (int ai = 0; ai < 2; ++ai)
#pragma unroll
            for (int m = 0; m < 4; ++m) { bf16_t* rowp = p0 + (size_t)PG8_ROWOFF(ai, m) * DFF;
#pragma unroll
                for (int bj = 0; bj < 2; ++bj) { f32x4 v0 = acc[ai][bj][m][0], v1 = acc[ai][bj][m][1];
                    F.apply(R, v0, v1, ai * 4 + m, bj);
#pragma unroll
                    for (int j = 0; j < 4; ++j) { const float a = fmaxf(v0[j], 0.f), b = fmaxf(v1[j], 0.f); v0[j] = a * a; v1[j] = b * b; }
                    *(u32x4*)(rowp + bj * HALF) = pack8(v0, v1); }
                PG8_PAIR_FENCE(m); }
    }
};
}

struct Args { const float* in[20]; float* out; unsigned char* ws; };
#define CAS __attribute__((address_space(4)))
__device__ __forceinline__ const CAS char* kernarg_base() { const CAS char* ka = (const CAS char*)__builtin_amdgcn_kernarg_segment_ptr(); asm volatile("" : "+s"(ka)); return ka; }
__device__ __forceinline__ const float* arg_in(int i) { return (const float*)*(const __attribute__((address_space(1))) float* const CAS*)(kernarg_base() + 8 * i); }
__device__ __forceinline__ float* arg_out() { return (float*)*(__attribute__((address_space(1))) float* const CAS*)(kernarg_base() + 8 * 20); }
__device__ __forceinline__ unsigned char* arg_ws() { return (unsigned char*)*(__attribute__((address_space(1))) unsigned char* const CAS*)(kernarg_base() + 8 * 21); }
enum { I_XP = 0, I_XS, I_WIN, I_WPOOL, I_SPOOL, I_SLNG, I_SLNB, I_WS, I_BS, I_RPB, I_WBRP, I_WBRS, I_WBRN, I_WOUT, I_LN1G, I_LN1B, I_WUP, I_WDN, I_LN2G, I_LN2B };

__device__ __forceinline__ void transpose_item(const float* W, int K, int N, bf16* WT, LAS float* scr, int item, int lane, const float* gk, const float* bk, float* csg, float* csb) {
    const int nblk = N / 32, kb = item / nblk, nb = item % nblk, k0 = 64 * kb, n0 = 32 * nb;
    float wv[32];
#pragma unroll
    for (int i = 0; i < 32; ++i) wv[i] = W[(size_t)(k0 + 2 * i + (lane >> 5)) * N + n0 + (lane & 31)];
#pragma unroll
    for (int i = 0; i < 32; ++i) scr[(2 * i + (lane >> 5)) * 33 + (lane & 31)] = wv[i];
    LDS_WAIT(); asm volatile("" ::: "memory");
    const int c = lane & 7;
    f32x4 ga = (f32x4){1.f, 1.f, 1.f, 1.f}, gb = ga;
    if (gk) {
        ga = *(const GAS f32x4*)(gk + k0 + 8 * c); gb = *(const GAS f32x4*)(gk + k0 + 8 * c + 4);
        const int n = lane & 31, hf = lane >> 5; const float* vec = hf ? bk : gk; float s = 0.f;
        for (int kk = 0; kk < 64; ++kk) { const float p = vec[k0 + kk] * scr[kk * 33 + n]; s += hf ? p : __uint_as_float(f2bf(p) << 16); }
        __hip_atomic_fetch_add((hf ? csb : csg) + n0 + n, s, __ATOMIC_RELAXED, __HIP_MEMORY_SCOPE_AGENT);
    }
#pragma unroll
    for (int j = 0; j < 4; ++j) { const int n = (lane >> 3) + 8 * j; const LAS float* s = scr + (8 * c) * 33 + n;
        v4u o; o.x = pk2(s[0 * 33] * ga.x, s[1 * 33] * ga.y); o.y = pk2(s[2 * 33] * ga.z, s[3 * 33] * ga.w); o.z = pk2(s[4 * 33] * gb.x, s[5 * 33] * gb.y); o.w = pk2(s[6 * 33] * gb.z, s[7 * 33] * gb.w);
        *(GAS v4u*)(WT + (size_t)(n0 + n) * K + k0 + 8 * c) = o; }
    LDS_WAIT(); asm volatile("" ::: "memory");
}

__device__ __forceinline__ void ln_row(float* row, bf16* xb, const float* g, const float* b, int lane) {
    GAS f32x4* xr = (GAS f32x4*)row + lane;
    f32x4 v[8]; float s = 0.f;
#pragma unroll
    for (int j = 0; j < 8; ++j) { v[j] = xr[64 * j]; s += (v[j].x + v[j].y) + (v[j].z + v[j].w); }
    const float mean = wave_sum(s) * (1.f / DM); float s2 = 0.f;
#pragma unroll
    for (int j = 0; j < 8; ++j) { v[j] = v[j] - mean; s2 += (v[j].x * v[j].x + v[j].y * v[j].y) + (v[j].z * v[j].z + v[j].w * v[j].w); }
    const float rstd = 1.f / sqrtf(wave_sum(s2) * (1.f / DM) + LN_EPS);
    const GAS f32x4* gp = (const GAS f32x4*)g + lane; const GAS f32x4* bp = (const GAS f32x4*)b + lane;
#pragma unroll
    for (int j = 0; j < 8; ++j) { const f32x4 y = v[j] * rstd * gp[64 * j] + bp[64 * j]; xr[64 * j] = y;
        if (xb) { v2u o; o.x = pk2(y.x, y.y); o.y = pk2(y.z, y.w); *((GAS v2u*)xb + lane + 64 * j) = o; } }
}

template <int HW> __device__ __forceinline__ void pool_quad(const bf16* zp, LAS unsigned char* dst, int pitch, int pos0, int seqlen) {
    constexpr int NR = 2 * HW + 3;
    v4u w[NR];
#pragma unroll
    for (int i = 0; i < NR; ++i) { const int d = i - HW, t = pos0 + d; const bool ok = (t >= 0) && (t < seqlen);
        v4u z; z.x = 0u; z.y = 0u; z.z = 0u; z.w = 0u; if (ok) z = *(const GAS v4u*)(zp + (ptrdiff_t)d * 1024); w[i] = z; }
    float s[8] = {0.f, 0.f, 0.f, 0.f, 0.f, 0.f, 0.f, 0.f};
#pragma unroll
    for (int i = 0; i < 2 * HW; ++i) { s[0] += bflo(w[i].x); s[1] += bfhi(w[i].x); s[2] += bflo(w[i].y); s[3] += bfhi(w[i].y); s[4] += bflo(w[i].z); s[5] += bfhi(w[i].z); s[6] += bflo(w[i].w); s[7] += bfhi(w[i].w); }
#pragma unroll
    for (int k = 0; k < 4; ++k) {
        if (k > 0) { const v4u a = w[2 * HW + k - 1], b = w[k - 1];
            s[0] += bflo(a.x) - bflo(b.x); s[1] += bfhi(a.x) - bfhi(b.x); s[2] += bflo(a.y) - bflo(b.y); s[3] += bfhi(a.y) - bfhi(b.y);
            s[4] += bflo(a.z) - bflo(b.z); s[5] += bfhi(a.z) - bfhi(b.z); s[6] += bflo(a.w) - bflo(b.w); s[7] += bfhi(a.w) - bfhi(b.w); }
        const int pos = pos0 + k; const float inv = 1.0f / (float)(min(pos + HW, seqlen) - max(pos - HW, 0)); const v4u c = w[HW + k];
        v4u o; o.x = pk2(s[0] * inv - bflo(c.x), s[1] * inv - bfhi(c.x)); o.y = pk2(s[2] * inv - bflo(c.y), s[3] * inv - bfhi(c.y));
        o.z = pk2(s[4] * inv - bflo(c.z), s[5] * inv - bfhi(c.z)); o.w = pk2(s[6] * inv - bflo(c.w), s[7] * inv - bfhi(c.w));
        *(LAS v4u*)(dst + k * pitch) = o; }
}

#define WSP(T, off) ((T*)(arg_ws() + (off)))
__device__ __forceinline__ const float* chunk_x0(int c) { return (c * CH < PROMPT_ROWS) ? arg_in(I_XP) + (size_t)c * CH * DM : arg_in(I_XS) + ((size_t)c * CH - PROMPT_ROWS) * DM; }
__device__ __forceinline__ float* chunk_R(int c) { return arg_out() + (size_t)c * CH * DM; }

__global__ void __launch_bounds__(512, 2) fwd_kernel(Args args) {
    extern __shared__ __attribute__((aligned(16))) unsigned char lds_raw[];
    LAS unsigned char* lds = (LAS unsigned char*)lds_raw;
    volatile LAS unsigned* MISC = (volatile LAS unsigned*)(lds + MISC_OFF);
    const int tid0 = threadIdx.x;
#define FRESH_TID() int tid = tid0; asm volatile("" : "+v"(tid)); const int lane = tid & 63, wave = __builtin_amdgcn_readfirstlane(tid >> 6); const int gw = bx * 8 + wave, gt = bx * 512 + tid; (void)lane; (void)gw; (void)gt
    const int G = gridDim.x, bx = blockIdx.x;
    for (int u = tid0; u < (LDS_BYTES - MISC_OFF) / 4; u += 512) ((LAS unsigned*)(lds + MISC_OFF))[u] = 0u;
    __syncthreads();
    XcdBarrier bar = xcd_barrier_post((unsigned*)(args.ws + WS_CTL) + CW_BAR, MISC + 8);
#define GRID_BAR() xcd_barrier(bar)
    const int NGW = G * 8, NGT = G * 512;

    {
                FRESH_TID();
        LAS float* scr = (LAS float*)(lds + RING_OFF + wave * 16384);
        constexpr int IT_IN = (DM / 64) * (DIN / 32), IT_BR = (1024 / 64) * (DM / 32), IT_OUT = (DM / 64) * (DM / 32), IT_UP = (DM / 64) * (DFF / 32), IT_DN = (DFF / 64) * (DM / 32), IT_PL = (256 / 64) * (256 / 32);
        constexpr int IT_LAYER = IT_IN + 3 * IT_BR + IT_OUT + IT_UP + IT_DN + 4 * IT_PL;
        for (int it = gw; it < DEPTH * IT_LAYER; it += NGW) {
            const int l = it / IT_LAYER; int r = it % IT_LAYER;
            if (r < IT_IN) { float* cs = WSP(float, WS_CTL + CS_OFF);
                transpose_item(arg_in(I_WIN) + (size_t)l * DM * DIN, DM, DIN, WSP(bf16, WS_WIN) + (size_t)l * DIN * DM, scr, r, lane, l ? arg_in(I_LN2G) : (const float*)nullptr, l ? arg_in(I_LN2B) : (const float*)nullptr, cs + CS_WIN_G, cs + CS_WIN_B); continue; } r -= IT_IN;
            if (r < 3 * IT_BR) { const int b = r / IT_BR; transpose_item(arg_in(I_WBRP + b) + (size_t)l * 1024 * DM, 1024, DM, WSP(bf16, WS_WBR) + (size_t)(l * 3 + b) * DM * 1024, scr, r % IT_BR, lane, nullptr, nullptr, nullptr, nullptr); continue; } r -= 3 * IT_BR;
            if (r < IT_OUT) { transpose_item(arg_in(I_WOUT) + (size_t)l * DM * DM, DM, DM, WSP(bf16, WS_WOUT) + (size_t)l * DM * DM, scr, r, lane, nullptr, nullptr, nullptr, nullptr); continue; } r -= IT_OUT;
            if (r < IT_UP) { float* cs = WSP(float, WS_CTL + CS_OFF);
                transpose_item(arg_in(I_WUP) + (size_t)l * DM * DFF, DM, DFF, WSP(bf16, WS_WUP) + (size_t)l * DFF * DM, scr, r, lane, arg_in(I_LN1G) + l * DM, arg_in(I_LN1B) + l * DM, cs + CS_WUP_G + l * DFF, cs + CS_WUP_B + l * DFF); continue; } r -= IT_UP;
            if (r < IT_DN) { transpose_item(arg_in(I_WDN) + (size_t)l * DFF * DM, DFF, DM, WSP(bf16, WS_WDN) + (size_t)l * DM * DFF, scr, r, lane, nullptr, nullptr, nullptr, nullptr); continue; } r -= IT_DN;
            { const int gI = r / IT_PL; transpose_item(arg_in(I_WPOOL) + (size_t)(l * 4 + gI) * 65536, 256, 256, WSP(bf16, WS_WPOOL) + (size_t)(l * 4 + gI) * 65536, scr, r % IT_PL, lane, nullptr, nullptr, nullptr, nullptr); }
        }
    }
    {
        FRESH_TID();
        const float* rpb = arg_in(I_RPB); bf16* tb = WSP(bf16, WS_NATB);
        for (int e = gt; e < DEPTH * NA_HEADS * 15 * 4 * 2 * 64; e += NGT) {
            const int ln = e & 63, ch = (e >> 6) & 1, jq = (e >> 7) & 3, rest = e >> 9, dr = rest % 15, lh = rest / 15;
            const int qc = 16 * jq + (ln & 15), c0 = min(max(qc - NA_KW / 2, 0), GRID_W - NA_KW), kc0 = (jq == 0) ? 0 : (jq == 1) ? 8 : (jq == 2) ? 24 : 32;
            float v[4];
#pragma unroll
            for (int i = 0; i < 4; ++i) { const int kc = kc0 + 16 * ch + 4 * (ln >> 4) + i; const bool ok = (unsigned)(kc - c0) < (unsigned)NA_KW; v[i] = ok ? rpb[(size_t)(lh * 15 + dr) * 31 + (kc - qc + NA_KW - 1)] : -1.0e30f; }
            v2u o; o.x = pk2(v[0], v[1]); o.y = pk2(v[2], v[3]); *((GAS v2u*)tb + e) = o;
        }
    }
    {
        FRESH_TID();
        const float* w = arg_in(I_WS); bf16* o = WSP(bf16, WS_WSB);
        for (int i = gt; i < DEPTH * 8 * 16384 / 4; i += NGT) { const f32x4 a = *((const GAS f32x4*)w + i); v2u p; p.x = pk2(a.x, a.y); p.y = pk2(a.z, a.w); *((GAS v2u*)o + i) = p; }
    }
    GRID_BAR();

    for (int c = 0; c < NCHUNK; ++c) {
        const int seqlen = (c * CH < PROMPT_ROWS) ? SEQ_P : SEQ_S;
        {
                FRESH_TID();
            const float* x0 = chunk_x0(c); bf16* XB = WSP(bf16, WS_XB);
            for (size_t i = gt; i < (size_t)CH * DM / 8; i += NGT) {
                const f32x4 a = *((const GAS f32x4*)x0 + 2 * i), b = *((const GAS f32x4*)x0 + 2 * i + 1);
                v4u o; o.x = pk2(a.x, a.y); o.y = pk2(a.z, a.w); o.z = pk2(b.x, b.y); o.w = pk2(b.z, b.w);
                *((GAS v4u*)XB + i) = o;
            }
            float* st = WSP(float, WS_STATS);
            float zf = 0.f; asm volatile("" : "+v"(zf));
            for (int i = gt; i < 4 * CH * 2 / 4; i += NGT) *((GAS f32x4*)st + i) = (f32x4){zf, zf, zf, zf};
        }
        GRID_BAR();
        for (int l = 0; l < DEPTH; ++l) {
            {
                pg8::Gemm g{WSP(bf16, WS_XB), WSP(bf16, WS_WIN) + (size_t)l * DIN * DM, DM, DM, DM, 0, 0, 0}; pg8::StaticOrder S; S.init(CH, DIN, G, bx);
                const float* cs = WSP(float, WS_CTL + CS_OFF);
                pg8::EpiZ E{WSP(bf16, WS_Z6), WSP(bf16, WS_G), pg8::LnFold{l ? WSP(float, WS_STATS) + 1 * CH * 2 : (const float*)nullptr, cs + CS_WIN_G, cs + CS_WIN_B}};
                pg8::gemm_phase<pg8::EpiZ, pg8::StaticOrder, PG8_ALIGN, PG8_SP2>(lds + RING_OFF, g, S, E);
            }
            GRID_BAR();
            {
                FRESH_TID();
                const bf16* Za = WSP(bf16, WS_Z6); bf16* PA = WSP(bf16, WS_P3);
                const bf16* wpt = WSP(bf16, WS_WPOOL) + (size_t)l * 4 * 65536; const float* spl = arg_in(I_SPOOL) + l * 1024;
                LAS unsigned char* PI = lds + RING_OFF; constexpr int PPITCH = 528;
                const int n = lane & 15, g4 = lane >> 4;
#pragma unroll 1
                for (int un = bx; un < (CH / 256) * 4; un += G) {
                    const int gI = un & 3, row0 = (un >> 2) * 256;
#pragma unroll 1
                    for (int it = 0; it < 4; ++it) {
                        const int idx = tid + 512 * it, qd = idx >> 5, j8 = idx & 31, lr0 = row0 + 4 * qd, pos0 = lr0 % seqlen;
                        const bf16* zp = Za + (size_t)lr0 * 1024 + gI * 256 + 8 * j8; LAS unsigned char* dp = PI + (4 * qd) * PPITCH + j8 * 16;
                        if (gI == 0) pool_quad<1>(zp, dp, PPITCH, pos0, seqlen); else if (gI == 1) pool_quad<2>(zp, dp, PPITCH, pos0, seqlen); else if (gI == 2) pool_quad<4>(zp, dp, PPITCH, pos0, seqlen); else pool_quad<8>(zp, dp, PPITCH, pos0, seqlen);
                    }
                    pg8::bf16x8 wf[2][8];
#pragma unroll
                    for (int nt = 0; nt < 2; ++nt)
#pragma unroll
                        for (int ks = 0; ks < 8; ++ks) wf[nt][ks] = *(const GAS pg8::bf16x8*)(wpt + (size_t)gI * 65536 + (size_t)(32 * wave + 16 * nt + n) * 256 + 32 * ks + 8 * g4);
                    f32x4 sp4[2];
#pragma unroll
                    for (int nt = 0; nt < 2; ++nt) sp4[nt] = *(const GAS f32x4*)(spl + gI * 256 + 32 * wave + 16 * nt + 4 * g4);
                    __syncthreads();
#pragma unroll 1
                    for (int mt = 0; mt < 16; ++mt) {
                        f32x4 acc[2] = {(f32x4){0.f, 0.f, 0.f, 0.f}, (f32x4){0.f, 0.f, 0.f, 0.f}};
                        const LAS unsigned char* pr = PI + (16 * mt + n) * PPITCH + g4 * 16;
#pragma unroll
                        for (int ks = 0; ks < 8; ++ks) { const pg8::bf16x8 pf = *(const LAS pg8::bf16x8*)(pr + ks * 64);
#pragma unroll
                            for (int nt = 0; nt < 2; ++nt) acc[nt] = __builtin_amdgcn_mfma_f32_16x16x32_bf16(wf[nt][ks], pf, acc[nt], 0, 0, 0); }
#pragma unroll
                        for (int nt = 0; nt < 2; ++nt) { v2u o; o.x = pk2(acc[nt][0] * sp4[nt].x, acc[nt][1] * sp4[nt].y); o.y = pk2(acc[nt][2] * sp4[nt].z, acc[nt][3] * sp4[nt].w);
                            *(GAS v2u*)(PA + (size_t)(row0 + 16 * mt + n) * 1024 + gI * 256 + 32 * wave + 16 * nt + 4 * g4) = o; }
                    }
                    __syncthreads();
                }
            }
            {
                FRESH_TID();
                const bf16* Zu = WSP(bf16, WS_Z6) + ZSTRIDE; const bf16* Zv = WSP(bf16, WS_Z6) + 2 * ZSTRIDE; bf16* PB = WSP(bf16, WS_P3) + ZSTRIDE;
                const float* lng = arg_in(I_SLNG) + l * 1024; const float* lnb = arg_in(I_SLNB) + l * 1024;
                const bf16* wsb = WSP(bf16, WS_WSB) + (size_t)l * 8 * 16384; const float* bsl = arg_in(I_BS) + l * 8 * 128;
                LAS unsigned char* VNI = lds + RING_OFF; LAS float* ST = (LAS float*)(lds + STATS_OFF);
                constexpr int VP = 1056;
                for (int un = bx; un < (CH / 128) * 2; un += G) {
                    const int nck = un >> 1, hq = un & 1, tok0 = nck * 128;
#pragma unroll 1
                    for (int th = 0; th < 2; ++th) {
                        v4u wv[8][2];
#pragma unroll
                        for (int tt = 0; tt < 8; ++tt) { const bf16* rp = Zv + (size_t)(tok0 + wave * 16 + th * 8 + tt) * 1024 + lane * 16; wv[tt][0] = *(const GAS v4u*)rp; wv[tt][1] = *(const GAS v4u*)(rp + 8); }
#pragma unroll
                        for (int tt = 0; tt < 8; ++tt) { const v4u w0 = wv[tt][0], w1 = wv[tt][1];
                            float x[16] = {bflo(w0.x), bfhi(w0.x), bflo(w0.y), bfhi(w0.y), bflo(w0.z), bfhi(w0.z), bflo(w0.w), bfhi(w0.w), bflo(w1.x), bfhi(w1.x), bflo(w1.y), bfhi(w1.y), bflo(w1.z), bfhi(w1.z), bflo(w1.w), bfhi(w1.w)};
                            float s = 0.f;
#pragma unroll
                            for (int j = 0; j < 16; ++j) s += x[j];
                            const float mean = wave_sum(s) * (1.f / 1024.f); float s2 = 0.f;
#pragma unroll
                            for (int j = 0; j < 16; ++j) { const float d = x[j] - mean; s2 += d * d; }
                            const float rstd = 1.f / sqrtf(wave_sum(s2) * (1.f / 1024.f) + LN_EPS);
                            if (lane == 0) { const int tk = wave * 16 + th * 8 + tt; ST[2 * tk] = mean; ST[2 * tk + 1] = rstd; } }
                    }
                    __syncthreads();
#pragma unroll 1
                    for (int ih = 0; ih < 2; ++ih) {
                        v4u wv[8];
#pragma unroll
                        for (int i = 0; i < 8; ++i) { const int idx = tid + 512 * (ih * 8 + i), q = idx >> 6, c8 = (idx & 63) * 8; wv[i] = *(const GAS v4u*)(Zv + (size_t)(tok0 + q) * 1024 + hq * 512 + c8); }
                        const int c8 = (tid & 63) * 8;
                        const f32x4 g0 = *(const GAS f32x4*)(lng + hq * 512 + c8), g1 = *(const GAS f32x4*)(lng + hq * 512 + c8 + 4), b0 = *(const GAS f32x4*)(lnb + hq * 512 + c8), b1 = *(const GAS f32x4*)(lnb + hq * 512 + c8 + 4);
#pragma unroll
                        for (int i = 0; i < 8; ++i) { const int idx = tid + 512 * (ih * 8 + i), q = idx >> 6; const v4u w = wv[i];
                            const float mean = ST[2 * q], rstd = ST[2 * q + 1];
                            v4u o; o.x = pk2((bflo(w.x) - mean) * rstd * g0.x + b0.x, (bfhi(w.x) - mean) * rstd * g0.y + b0.y); o.y = pk2((bflo(w.y) - mean) * rstd * g0.z + b0.z, (bfhi(w.y) - mean) * rstd * g0.w + b0.w);
                            o.z = pk2((bflo(w.z) - mean) * rstd * g1.x + b1.x, (bfhi(w.z) - mean) * rstd * g1.y + b1.y); o.w = pk2((bflo(w.w) - mean) * rstd * g1.z + b1.z, (bfhi(w.w) - mean) * rstd * g1.w + b1.w);
                            *(LAS v4u*)(VNI + q * VP + c8 * 2) = o; }
                    }
                    __syncthreads();
                    const int n = lane & 15, g4 = lane >> 4, p = wave * 16 + n;
                    const LAS unsigned char* ap = VNI + (8 * g4 + ((lane & 15) >> 2)) * VP + (lane & 3) * 8;
                    pg8::bf16x8 wfN[4]; v2u uN[8]; float bsN;
#define SGU_FETCH(GI) do { const int gI_ = hq * 4 + (GI); \
                        _Pragma("unroll") for (int ks = 0; ks < 4; ++ks) wfN[ks] = *(const GAS pg8::bf16x8*)(wsb + (size_t)gI_ * 16384 + p * 128 + 32 * ks + 8 * g4); \
                        _Pragma("unroll") for (int ct = 0; ct < 8; ++ct) uN[ct] = *(const GAS v2u*)(Zu + (size_t)(tok0 + p) * 1024 + gI_ * 128 + ct * 16 + 4 * g4); \
                        bsN = bsl[gI_ * 128 + p]; } while (0)
                    SGU_FETCH(0);
#pragma unroll 1
                    for (int gi = 0; gi < 4; ++gi) {
                        const int gI = hq * 4 + gi;
                        pg8::bf16x8 wf[4]; v2u uw[8];
#pragma unroll
                        for (int ks = 0; ks < 4; ++ks) wf[ks] = wfN[ks];
#pragma unroll
                        for (int ct = 0; ct < 8; ++ct) uw[ct] = uN[ct];
                        const float bsv = bsN;
                        SGU_FETCH(min(gi + 1, 3));
#pragma unroll
                        for (int ct = 0; ct < 8; ++ct) {
                            f32x4 acc = (f32x4){0.f, 0.f, 0.f, 0.f};
#pragma unroll
                            for (int ks = 0; ks < 4; ++ks) { const LAS unsigned char* a = ap + ks * 32 * VP + (gi * 128 + ct * 16) * 2;
                                typedef short v4s __attribute__((ext_vector_type(4)));
                                const v4s t0 = __builtin_amdgcn_ds_read_tr16_b64_v4i16((LAS v4s*)a), t1 = __builtin_amdgcn_ds_read_tr16_b64_v4i16((LAS v4s*)(a + 4 * VP));
                                const pg8::bf16x8 vf = __builtin_shufflevector(t0, t1, 0, 1, 2, 3, 4, 5, 6, 7);
                                acc = __builtin_amdgcn_mfma_f32_16x16x32_bf16(vf, wf[ks], acc, 0, 0, 0); }
                            const size_t off = (size_t)(tok0 + p) * 1024 + gI * 128 + ct * 16 + 4 * g4;
                            v2u o; o.x = pk2(bflo(uw[ct].x) * (acc[0] + bsv), bfhi(uw[ct].x) * (acc[1] + bsv)); o.y = pk2(bflo(uw[ct].y) * (acc[2] + bsv), bfhi(uw[ct].y) * (acc[3] + bsv));
                            *(GAS v2u*)(PB + off) = o;
                        }
                    }
#undef SGU_FETCH
                    __syncthreads();
                }
            }
            {
                FRESH_TID();
                const bf16* Qb = WSP(bf16, WS_Z6) + 3 * ZSTRIDE; const bf16* Kb = Qb + ZSTRIDE; const bf16* Vb = Kb + ZSTRIDE; bf16* PC = WSP(bf16, WS_P3) + 2 * ZSTRIDE;
                const bf16* tbl = WSP(bf16, WS_NATB) + (size_t)l * NA_HEADS * 15 * 4 * 2 * 256;
                const int rows = seqlen / GRID_W, NUN = (CH / GRID_W / 2) * NA_HEADS;
                LAS unsigned char* Ks = lds + RING_OFF; LAS unsigned char* Vs = lds + RING_OFF + 9 * 8192;
                const int n = lane & 15, g4 = lane >> 4, jq = wave & 3, rr = wave >> 2;
                const int kc0 = (jq == 0) ? 0 : (jq == 1) ? 8 : (jq == 2) ? 24 : 32;
                const int qcol = 16 * jq + n;
                int koff[2][2], voff[2][4];
#pragma unroll
                for (int ch = 0; ch < 2; ++ch)
#pragma unroll
                    for (int ks = 0; ks < 2; ++ks) { const int kc = kc0 + 16 * ch + n; koff[ch][ks] = kc * 128 + (((4 * ks + g4) ^ (kc & 7)) * 16); }
#pragma unroll
                for (int t1 = 0; t1 < 2; ++t1)
#pragma unroll
                    for (int dt = 0; dt < 4; ++dt) { const int kc = kc0 + 16 * t1 + 4 * g4 + ((lane & 15) >> 2), p = lane & 3; voff[t1][dt] = kc * 128 + (((2 * dt + (p >> 1)) ^ (kc & 7)) * 16) + 8 * (p & 1); }
                const int st_key = tid >> 3, st_off = st_key * 128 + (((tid & 7) ^ (st_key & 7)) * 16);
                v4u kreg[9], vreg[9]; pg8::bf16x8 qf[2]; int qtok = 0;
#define NA_FETCH(UN) do { const int h_ = (UN) & 15, gp_ = (UN) >> 4, sq_ = gp_ / (rows / 2), rp_ = gp_ % (rows / 2), rb_ = min(max(2 * rp_ - NA_KH / 2, 0), rows - NA_KH); \
                    const size_t gb_ = (size_t)(sq_ * seqlen + rb_ * GRID_W) * 1024 + h_ * 64 + (tid & 7) * 8 + (size_t)(tid >> 3) * 1024; \
                    _Pragma("unroll") for (int i = 0; i < 9; ++i) { kreg[i] = *(const GAS v4u*)(Kb + gb_ + (size_t)i * 64 * 1024); vreg[i] = *(const GAS v4u*)(Vb + gb_ + (size_t)i * 64 * 1024); } \
                    qtok = sq_ * seqlen + (2 * rp_ + rr) * GRID_W + qcol; \
                    _Pragma("unroll") for (int ks = 0; ks < 2; ++ks) qf[ks] = *(const GAS pg8::bf16x8*)(Qb + (size_t)qtok * 1024 + h_ * 64 + 32 * ks + 8 * g4); } while (0)
                NA_FETCH(min(bx, NUN - 1));
#pragma unroll 1
                for (int un = bx; un < NUN; un += G) {
                    const int h = un & 15, gp = un >> 4, rp = gp % (rows / 2);
                    const int r = 2 * rp + rr, rbase = min(max(2 * rp - NA_KH / 2, 0), rows - NA_KH), r0 = min(max(r - NA_KH / 2, 0), rows - NA_KH), jo = r0 - rbase;
#pragma unroll
                    for (int i = 0; i < 9; ++i) { *(LAS v4u*)(Ks + i * 8192 + st_off) = kreg[i]; *(LAS v4u*)(Vs + i * 8192 + st_off) = vreg[i]; }
                    const pg8::bf16x8 qc0 = qf[0], qc1 = qf[1]; const int qtok_c = qtok;
                    __syncthreads();
                    NA_FETCH(min(un + G, NUN - 1));
                    const bf16* tb = tbl + (size_t)((h * 15 + (r0 - r + NA_KH - 1)) * 4 + jq) * 2 * 256 + lane * 4;
                    v2u bt[16];
#pragma unroll
                    for (int jr = 0; jr < 8; ++jr)
#pragma unroll
                        for (int ch = 0; ch < 2; ++ch) bt[jr * 2 + ch] = *(const GAS v2u*)(tb + (size_t)jr * (4 * 2 * 256) + ch * 256);
                    f32x4 s[16];
                    const LAS unsigned char* kb = Ks + jo * 8192; const LAS unsigned char* vb = Vs + jo * 8192;
#pragma unroll
                    for (int jr = 0; jr < 8; ++jr)
#pragma unroll
                        for (int ch = 0; ch < 2; ++ch) {
                            const pg8::bf16x8 a0 = *(const LAS pg8::bf16x8*)(kb + jr * 8192 + koff[ch][0]), a1 = *(const LAS pg8::bf16x8*)(kb + jr * 8192 + koff[ch][1]);
                            f32x4 z = (f32x4){0.f, 0.f, 0.f, 0.f};
                            z = __builtin_amdgcn_mfma_f32_16x16x32_bf16(a0, qc0, z, 0, 0, 0);
                            s[jr * 2 + ch] = __builtin_amdgcn_mfma_f32_16x16x32_bf16(a1, qc1, z, 0, 0, 0); }
                    float mx = -1.0e30f;
#pragma unroll
                    for (int t = 0; t < 16; ++t) { s[t][0] += bflo(bt[t].x); s[t][1] += bfhi(bt[t].x); s[t][2] += bflo(bt[t].y); s[t][3] += bfhi(bt[t].y);
                        mx = fmaxf(mx, fmaxf(fmaxf(s[t][0], s[t][1]), fmaxf(s[t][2], s[t][3]))); }
                    mx = fmaxf(mx, __shfl_xor(mx, 16)); mx = fmaxf(mx, __shfl_xor(mx, 32));
                    const float mxl = mx * 1.4426950408889634f;
                    float sum = 0.f;
#pragma unroll
                    for (int t = 0; t < 16; ++t)
#pragma unroll
                        for (int i = 0; i < 4; ++i) { const float p = __builtin_amdgcn_exp2f(s[t][i] * 1.4426950408889634f - mxl); s[t][i] = p; sum += p; }
                    sum += __shfl_xor(sum, 16); sum += __shfl_xor(sum, 32);
                    const float inv = 1.0f / sum;
                    f32x4 o[4];
#pragma unroll
                    for (int dt = 0; dt < 4; ++dt) o[dt] = (f32x4){0.f, 0.f, 0.f, 0.f};
#pragma unroll
                    for (int jr = 0; jr < 8; ++jr) {
                        pg8::u32x4 pw; pw.x = pg8::cvt_pk_bf16(s[2 * jr][0], s[2 * jr][1]); pw.y = pg8::cvt_pk_bf16(s[2 * jr][2], s[2 * jr][3]);
                        pw.z = pg8::cvt_pk_bf16(s[2 * jr + 1][0], s[2 * jr + 1][1]); pw.w = pg8::cvt_pk_bf16(s[2 * jr + 1][2], s[2 * jr + 1][3]);
                        const pg8::bf16x8 pf = __builtin_bit_cast(pg8::bf16x8, pw);
#pragma unroll
                        for (int dt = 0; dt < 4; ++dt) {
                            typedef short v4s __attribute__((ext_vector_type(4)));
                            const v4s t0 = __builtin_amdgcn_ds_read_tr16_b64_v4i16((LAS v4s*)(vb + jr * 8192 + voff[0][dt])), t1 = __builtin_amdgcn_ds_read_tr16_b64_v4i16((LAS v4s*)(vb + jr * 8192 + voff[1][dt]));
                            const pg8::bf16x8 vf = __builtin_shufflevector(t0, t1, 0, 1, 2, 3, 4, 5, 6, 7);
                            o[dt] = __builtin_amdgcn_mfma_f32_16x16x32_bf16(vf, pf, o[dt], 0, 0, 0); }
                    }
#pragma unroll
                    for (int dt = 0; dt < 4; ++dt) { v2u ov; ov.x = pk2(o[dt][0] * inv, o[dt][1] * inv); ov.y = pk2(o[dt][2] * inv, o[dt][3] * inv);
                        *(GAS v2u*)(PC + (size_t)qtok_c * 1024 + h * 64 + 16 * dt + 4 * g4) = ov; }
                    __syncthreads();
                }
#undef NA_FETCH
            }
            GRID_BAR();
            {
                pg8::Gemm g{WSP(bf16, WS_P3), WSP(bf16, WS_WBR) + (size_t)l * 3 * DM * 1024, 1024, 1024, 1024, 0, ZSTRIDE * 2, (size_t)DM * 1024 * 2}; pg8::TripleOrder S; S.init(CH, DM, G, bx, 4);
                pg8::EpiGate E{WSP(bf16, WS_G), WSP(bf16, WS_MERGED)};
                pg8::gemm_phase<pg8::EpiGate, pg8::TripleOrder, PG8_ALIGN, PG8_SP2>(lds + RING_OFF, g, S, E);
            }
            GRID_BAR();
            {
                pg8::Gemm g{WSP(bf16, WS_MERGED), WSP(bf16, WS_WOUT) + (size_t)l * DM * DM, DM, DM, DM, 0, 0, 0}; pg8::StaticOrder S; S.init(CH, DM, G, bx, 4);
                float* st = WSP(float, WS_STATS);
                pg8::EpiResLn E{l == 0 ? chunk_x0(c) : (const float*)nullptr, (float*)nullptr, WSP(float, WS_RF), WSP(bf16, WS_XB), l ? st + 1 * CH * 2 : (const float*)nullptr, arg_in(I_LN2G), arg_in(I_LN2B), st + (l ? 2 : 0) * CH * 2};
                pg8::gemm_phase<pg8::EpiResLn, pg8::StaticOrder, PG8_ALIGN, PG8_SP2>(lds + RING_OFF, g, S, E);
            }
            GRID_BAR();
            {
                pg8::Gemm g{WSP(bf16, WS_XB), WSP(bf16, WS_WUP) + (size_t)l * DFF * DM, DM, DM, DM, 0, 0, 0}; pg8::StaticOrder S; S.init(CH, DFF, G, bx);
                const float* cs = WSP(float, WS_CTL + CS_OFF);
                pg8::EpiSq E{WSP(bf16, WS_H), pg8::LnFold{WSP(float, WS_STATS) + (l ? 2 : 0) * CH * 2, cs + CS_WUP_G + l * DFF, cs + CS_WUP_B + l * DFF}};
                pg8::gemm_phase<pg8::EpiSq, pg8::StaticOrder, PG8_ALIGN, PG8_SP2>(lds + RING_OFF, g, S, E);
            }
            GRID_BAR();
            {
                pg8::Gemm g{WSP(bf16, WS_H), WSP(bf16, WS_WDN) + (size_t)l * DM * DFF, DFF, DFF, DFF, 0, 0, 0}; pg8::StaticOrder S; S.init(CH, DM, G, bx, 4);
                float* st = WSP(float, WS_STATS);
                pg8::EpiResLn E{(const float*)nullptr, l == 0 ? (float*)nullptr : chunk_R(c), WSP(float, WS_RF), l == 0 ? WSP(bf16, WS_XB) : (bf16*)nullptr, st + (l ? 2 : 0) * CH * 2, arg_in(I_LN1G) + l * DM, arg_in(I_LN1B) + l * DM, l == 0 ? st + 1 * CH * 2 : (float*)nullptr};
                pg8::gemm_phase<pg8::EpiResLn, pg8::StaticOrder, PG8_ALIGN, PG8_SP2>(lds + RING_OFF, g, S, E);
            }
            GRID_BAR();
        }
        {
            FRESH_TID();
            float* R = chunk_R(c); const float* lg = arg_in(I_LN2G) + (DEPTH - 1) * DM; const float* lb = arg_in(I_LN2B) + (DEPTH - 1) * DM;
            for (int m = gw; m < CH; m += NGW) ln_row(R + (size_t)m * DM, (bf16*)nullptr, lg, lb, lane);
        }
    }
#undef GRID_BAR
}

extern "C" void kernel_launch(void* const* d_in, const int* in_sizes, int n_in, void* d_out, int out_size, void* d_ws, size_t ws_size, hipStream_t stream) {
    static int grid = 0;
    if (grid == 0) {
        if (n_in != 20 || out_size != NTOK * DM || ws_size < WS_END) { fprintf(stderr, "kernel_launch: unexpected problem (n_in %d, out %d, ws %zu); nothing launched\n", n_in, out_size, ws_size); grid = -1; return; }
        int dev = 0, cus = 0, per_cu = 0;
        if (hipGetDevice(&dev) != hipSuccess || hipDeviceGetAttribute(&cus, hipDeviceAttributeMultiprocessorCount, dev) != hipSuccess) { grid = -1; return; }
        if (hipFuncSetAttribute((const void*)fwd_kernel, hipFuncAttributeMaxDynamicSharedMemorySize, LDS_BYTES) != hipSuccess) { fprintf(stderr, "kernel_launch: hipFuncSetAttribute failed\n"); grid = -1; return; }
        if (hipOccupancyMaxActiveBlocksPerMultiprocessor(&per_cu, (const void*)fwd_kernel, 512, LDS_BYTES) != hipSuccess || per_cu < 1) { fprintf(stderr, "kernel_launch: occupancy query says %d blocks per CU\n", per_cu); }
        (void)hipGetLastError();
        grid = cus;
    }
    if (grid < 0) return;
    if (hipMemsetAsync((char*)d_ws + WS_CTL, 0, CTL_ZERO_BYTES, stream) != hipSuccess) return;
    Args a{};
    for (int i = 0; i < 20; ++i) a.in[i] = (const float*)d_in[i];
    a.out = (float*)d_out; a.ws = (unsigned char*)d_ws;
    hipLaunchKernelGGL(fwd_kernel, dim3(grid), dim3(512), LDS_BYTES, stream, a);
}
```

```cpp
#include <hip/hip_runtime.h>
#include <cstdio>
#include <cstdint>

namespace pg8 {
#define PG8_LAS __attribute__((address_space(3)))
typedef unsigned short bf16_t;
typedef short bf16x8 __attribute__((ext_vector_type(8)));
typedef float f32x4 __attribute__((ext_vector_type(4)));
typedef float f32x2 __attribute__((ext_vector_type(2)));
typedef unsigned u32x4 __attribute__((ext_vector_type(4)));
typedef unsigned u32x2 __attribute__((ext_vector_type(2)));
constexpr int BM = 256, BK = 64, HALF = 128, HTB = HALF * BK * 2  , STAGE_BYTES = 8 * HTB, NXCD = 8, WGM = 8;

__host__ __device__ __forceinline__ int lds_byte(int r, int c) { const int st = (r >> 4) * 2 + (c >> 5), rr = r & 15, cc = c & 31, ob = rr * 64 + cc * 2; return st * 1024 + (ob ^ (((ob >> 9) & 1) << 5)); }
__host__ __device__ __forceinline__ void stage_rc(int b, int& R, int& C) { const int st = b / 1024, sb = b % 1024, swz = sb ^ (((sb >> 9) & 1) << 5); R = (st >> 1) * 16 + swz / 64; C = (st & 1) * 32 + (swz % 64) / 2; }
__host__ __device__ __forceinline__ int perm32(int rho) { const int n = rho >> 4, i = rho & 15; return 8 * (i >> 2) + 4 * n + (i & 3); }

struct Unit { int pm, pn, br; };
struct Gemm { const bf16_t* A; const bf16_t* Bt; int lda, ldb, K; size_t a_pn, a_br, b_br; };

struct StaticOrder {
    int nM, nN, nwg, G, c, wgm;
    __host__ __device__ void init(int M, int N, int G_, int c_, int wgm_ = WGM) { nM = M / BM; nN = N / BM; nwg = nM * nN; G = G_; c = c_; wgm = wgm_; }
    __host__ __device__ bool tile(long L, Unit& u) const {
        if (L >= nwg) return false;
        int wgid = (int)L; { const int q = nwg / NXCD, r = nwg % NXCD, xcd = wgid % NXCD, off = wgid / NXCD; wgid = (xcd < r ? xcd * (q + 1) : r * (q + 1) + (xcd - r) * q) + off; }
        const int nig = wgm * nN, gid = wgid / nig, fm = gid * wgm, gsz = (nM - fm) < wgm ? (nM - fm) : wgm;
        u.pm = fm + ((wgid % nig) % gsz); u.pn = (wgid % nig) / gsz; return true;
    }
    __host__ __device__ bool next(int i, Unit& u) const { u.br = 0; return tile((long)i * G + c, u); }
    __device__ __forceinline__ void a_ready(const Unit&) const {}
    __device__ __forceinline__ void done(const Unit&) const {}
};
struct TripleOrder : StaticOrder {
    __host__ __device__ bool next(int i, Unit& u) const { u.br = i % 3; return tile((long)(i / 3) * G + c, u); }
};

__device__ __forceinline__ unsigned cvt_pk_bf16(float lo, float hi) { unsigned r; asm volatile("v_cvt_pk_bf16_f32 %0, %1, %2" : "=v"(r) : "v"(lo), "v"(hi)); return r; }
__device__ __forceinline__ float bf_lo(unsigned w) { return __uint_as_float(w << 16); }
__device__ __forceinline__ float bf_hi(unsigned w) { return __uint_as_float(w & 0xffff0000u); }

template <class Epi, class Sched, bool ALIGN_EPI = false, bool SP2 = false>
__device__ __forceinline__ void gemm_phase(PG8_LAS unsigned char* lds, const Gemm g, const Sched& S, const Epi& E) {
    int tid = threadIdx.x; asm volatile("" : "+v"(tid));
    const int wid = __builtin_amdgcn_readfirstlane(tid >> 6), lane = tid & 63, wr = wid >> 2, wc = wid & 3, fr = lane & 15, fq = lane >> 4;
    const int K = g.K, nt = K / BK;
    unsigned voffA[2], voffB[2];
#pragma unroll
    for (int i = 0; i < 2; ++i) { int R, C; stage_rc(tid * 16 + i * 8192, R, C); const int Rb = Epi::PERM ? ((R & ~31) + perm32(R & 31)) : R;
        voffA[i] = (unsigned)(R * g.lda + C) * 2u; voffB[i] = (unsigned)(Rb * g.ldb + C) * 2u; }
    const size_t kstep = (size_t)(BK * 2);
    const size_t hstepA = (size_t)HALF * g.lda * 2, hstepB = (size_t)HALF * g.ldb * 2;
    const unsigned ldsw = (unsigned)wid * 1024u;
    const int aoff = lds_byte(wr * 64 + fr, fq * 8), boff = lds_byte(wc * 32 + fr, fq * 8);
#define PG8_SA(b, h) (((b) * 2 + (h)) * HTB)
#define PG8_SB(b, h) ((4 + (b) * 2 + (h)) * HTB)
#define PG8_STAGE(bufoff, gbase, voff) do { _Pragma("unroll") for (int _i = 0; _i < 2; ++_i) \
        __builtin_amdgcn_global_load_lds((const unsigned*)((const char*)(gbase) + (voff)[_i]), (PG8_LAS unsigned*)(lds + (bufoff) + ldsw + _i * 8192), 16, 0, 0); } while (0)
#define PG8_LDA(dst, b, h) do { _Pragma("unroll") for (int m = 0; m < 4; ++m) _Pragma("unroll") for (int k = 0; k < 2; ++k) dst[m][k] = *(const PG8_LAS bf16x8*)(lds + PG8_SA(b, h) + aoff + m * 2048 + k * 1024); } while (0)
#define PG8_LDB(dst, b, h) do { _Pragma("unroll") for (int n = 0; n < 2; ++n) _Pragma("unroll") for (int k = 0; k < 2; ++k) dst[n][k] = *(const PG8_LAS bf16x8*)(lds + PG8_SB(b, h) + boff + n * 2048 + k * 1024); } while (0)
#define PG8_MMA(ai, bj, At, Bt) do { __builtin_amdgcn_s_setprio(1); _Pragma("unroll") for (int m = 0; m < 4; ++m) _Pragma("unroll") for (int n = 0; n < 2; ++n) _Pragma("unroll") for (int k = 0; k < 2; ++k) \
        acc[ai][bj][m][n] = __builtin_amdgcn_mfma_f32_16x16x32_bf16(Bt[n][k], At[m][k], acc[ai][bj][m][n], 0, 0, 0); __builtin_amdgcn_s_setprio(0); } while (0)
#define PG8_WAIT_V(n) asm volatile("s_waitcnt vmcnt(" #n ")" ::: "memory")
#define PG8_WAIT_L(n) asm volatile("s_waitcnt lgkmcnt(" #n ")" ::: "memory")
#define PG8_BAR __builtin_amdgcn_s_barrier()
#define PG8_SCHED __builtin_amdgcn_sched_barrier(0)
#define PG8_UA(u) ((const char*)g.A + (size_t)(u).pm * 2 * hstepA + (size_t)(u).pn * g.a_pn + (size_t)(u).br * g.a_br)
#define PG8_UB(u) ((const char*)g.Bt + (size_t)(u).pn * 2 * hstepB + (size_t)(u).br * g.b_br)
    Unit cur, nxt; int ui = 0;
    if (!S.next(0, cur)) return;
    f32x4 acc[2][2][4][2];
#pragma unroll
    for (int a = 0; a < 2; ++a)
#pragma unroll
        for (int b = 0; b < 2; ++b)
#pragma unroll
            for (int m = 0; m < 4; ++m)
#pragma unroll
                for (int n = 0; n < 2; ++n) acc[a][b][m][n] = (f32x4){0.f, 0.f, 0.f, 0.f};
    bf16x8 At[4][2], B0[2][2], B1[2][2];
    const char* cA = PG8_UA(cur); const char* cB = PG8_UB(cur);
    S.a_ready(cur);
    if constexpr (SP2) {
        PG8_STAGE(PG8_SB(0, 0), cB, voffB); PG8_STAGE(PG8_SB(0, 1), cB + hstepB, voffB); PG8_STAGE(PG8_SA(0, 0), cA, voffA); PG8_STAGE(PG8_SA(0, 1), cA + hstepA, voffA);
        if (wr == 1) PG8_BAR;
        PG8_WAIT_V(2); PG8_BAR;
        PG8_STAGE(PG8_SB(1, 0), cB + kstep, voffB); PG8_STAGE(PG8_SA(1, 0), cA + kstep, voffA); PG8_STAGE(PG8_SB(1, 1), cB + hstepB + kstep, voffB);
        PG8_WAIT_V(6); PG8_BAR;
    } else {
        PG8_STAGE(PG8_SB(0, 0), cB, voffB); PG8_STAGE(PG8_SA(0, 0), cA, voffA); PG8_STAGE(PG8_SB(0, 1), cB + hstepB, voffB); PG8_STAGE(PG8_SA(0, 1), cA + hstepA, voffA);
        if (wr == 1) PG8_BAR;
        PG8_WAIT_V(4); PG8_BAR;
        PG8_STAGE(PG8_SB(1, 0), cB + kstep, voffB); PG8_STAGE(PG8_SA(1, 0), cA + kstep, voffA); PG8_STAGE(PG8_SB(1, 1), cB + hstepB + kstep, voffB);
        PG8_WAIT_V(6); PG8_BAR;
    }
    for (;;) {
        const bool has_next = S.next(ui + 1, nxt);
        const char* nA = has_next ? PG8_UA(nxt) : cA; const char* nB = has_next ? PG8_UB(nxt) : cB;
#pragma unroll 1
        for (int t = 0; t < nt; t += 2) {
            const bool last = (t == nt - 2);
            const char* a1 = cA + (size_t)(t + 1) * kstep;
            const char* a2 = last ? nA : cA + (size_t)(t + 2) * kstep; const char* b2 = last ? nB : cB + (size_t)(t + 2) * kstep;
            const char* a3 = a2 + kstep; const char* b3 = b2 + kstep;
            if (last && has_next) S.a_ready(nxt);
            if constexpr (SP2) {
            PG8_LDB(B0, 0, 0); PG8_LDB(B1, 0, 1); PG8_SCHED; PG8_LDA(At, 0, 0); PG8_STAGE(PG8_SA(1, 1), a1 + hstepA, voffA);
            PG8_WAIT_V(8); PG8_WAIT_L(0); PG8_BAR; PG8_MMA(0, 0, At, B0); PG8_MMA(0, 1, At, B1); PG8_BAR; PG8_SCHED;
            PG8_LDA(At, 0, 1); PG8_STAGE(PG8_SB(0, 0), b2, voffB); PG8_STAGE(PG8_SB(0, 1), b2 + hstepB, voffB); PG8_STAGE(PG8_SA(0, 0), a2, voffA);
            PG8_WAIT_V(8); PG8_WAIT_L(0); PG8_BAR; PG8_MMA(1, 0, At, B0); PG8_MMA(1, 1, At, B1); PG8_BAR; PG8_SCHED;
            PG8_LDB(B0, 1, 0); PG8_LDB(B1, 1, 1); PG8_SCHED; PG8_LDA(At, 1, 0); PG8_STAGE(PG8_SA(0, 1), a2 + hstepA, voffA);
            PG8_WAIT_V(8); PG8_WAIT_L(0); PG8_BAR; PG8_MMA(0, 0, At, B0); PG8_MMA(0, 1, At, B1); PG8_BAR; PG8_SCHED;
            PG8_LDA(At, 1, 1); PG8_STAGE(PG8_SB(1, 0), b3, voffB); PG8_STAGE(PG8_SB(1, 1), b3 + hstepB, voffB); PG8_STAGE(PG8_SA(1, 0), a3, voffA);
            PG8_WAIT_V(8); PG8_WAIT_L(0); PG8_BAR; PG8_MMA(1, 0, At, B0); PG8_MMA(1, 1, At, B1); PG8_BAR; PG8_SCHED;
            } else {
            PG8_LDB(B0, 0, 0); PG8_SCHED; PG8_LDA(At, 0, 0); PG8_STAGE(PG8_SA(1, 1), a1 + hstepA, voffA);
            PG8_WAIT_L(8); PG8_BAR; PG8_WAIT_L(0); PG8_MMA(0, 0, At, B0); PG8_BAR; PG8_SCHED;
            PG8_LDB(B1, 0, 1); PG8_STAGE(PG8_SB(0, 0), b2, voffB);
            PG8_BAR; PG8_WAIT_L(0); PG8_MMA(0, 1, At, B1); PG8_BAR;
            PG8_LDA(At, 0, 1); PG8_STAGE(PG8_SA(0, 0), a2, voffA);
            PG8_BAR; PG8_WAIT_L(0); PG8_MMA(1, 0, At, B0); PG8_BAR; PG8_SCHED;
            PG8_STAGE(PG8_SB(0, 1), b2 + hstepB, voffB);
            PG8_WAIT_V(6); PG8_BAR; PG8_MMA(1, 1, At, B1); PG8_BAR;
            PG8_LDB(B0, 1, 0); PG8_SCHED; PG8_LDA(At, 1, 0); PG8_STAGE(PG8_SA(0, 1), a2 + hstepA, voffA);
            PG8_WAIT_L(8); PG8_BAR; PG8_WAIT_L(0); PG8_MMA(0, 0, At, B0); PG8_BAR; PG8_SCHED;
            PG8_LDB(B1, 1, 1); PG8_STAGE(PG8_SB(1, 0), b3, voffB);
            PG8_BAR; PG8_WAIT_L(0); PG8_MMA(0, 1, At, B1); PG8_BAR;
            PG8_LDA(At, 1, 1); PG8_STAGE(PG8_SA(1, 0), a3, voffA);
            PG8_BAR; PG8_WAIT_L(0); PG8_MMA(1, 0, At, B0); PG8_BAR; PG8_SCHED;
            PG8_STAGE(PG8_SB(1, 1), b3 + hstepB, voffB);
            PG8_WAIT_V(6); PG8_BAR; PG8_MMA(1, 1, At, B1); PG8_BAR;
            }
        }
        if constexpr (ALIGN_EPI) { if (wr == 0) PG8_BAR; }
        E(acc, cur, wr, wc, fr, fq); S.done(cur);
        if (!has_next) break;
        if (!(Epi::CHAIN && cur.br < 2)) {
#pragma unroll
        for (int a = 0; a < 2; ++a)
#pragma unroll
            for (int b = 0; b < 2; ++b)
#pragma unroll
                for (int m = 0; m < 4; ++m)
#pragma unroll
                    for (int n = 0; n < 2; ++n) acc[a][b][m][n] = (f32x4){0.f, 0.f, 0.f, 0.f};
        }
        cur = nxt; cA = nA; cB = nB; ++ui;
        if constexpr (ALIGN_EPI) { if (wr == 1) PG8_BAR; }
    }
    PG8_WAIT_V(0);
    if constexpr (!ALIGN_EPI) { if (wr == 0) PG8_BAR; }
    PG8_BAR;
#undef PG8_UA
#undef PG8_UB
#undef PG8_SA
#undef PG8_SB
#undef PG8_STAGE
#undef PG8_LDA
#undef PG8_LDB
#undef PG8_MMA
#undef PG8_WAIT_V
#undef PG8_WAIT_L
#undef PG8_BAR
#undef PG8_SCHED
}
}
#define PG8_SP2 true
#define PG8_ALIGN true

constexpr int DM = 2048, DIN = 12288, DFF = 8192, DEPTH = 2;
constexpr int NTOK = 65536, CH = 16384, NCHUNK = NTOK / CH;
constexpr int SEQ_P = 8192, SEQ_S = 4096, PROMPT_ROWS = 32768;
constexpr int GRID_W = 64, NA_HEADS = 16, NA_KH = 8, NA_KW = 16;
constexpr float LN_EPS = 1e-5f;
constexpr float DN_ALPHA = 1.4142135623730951f;

constexpr size_t MiB = 1u << 20;
constexpr size_t WS_CTL = 0, CTL_ZERO_BYTES = 1 * MiB;
constexpr size_t WS_WIN = 1 * MiB;
constexpr size_t WS_WBR = 97 * MiB;
constexpr size_t WS_WOUT = 121 * MiB;
constexpr size_t WS_WUP = 137 * MiB;
constexpr size_t WS_WDN = 201 * MiB;
constexpr size_t WS_WPOOL = 265 * MiB;
constexpr size_t WS_WSB = 266 * MiB;
constexpr size_t WS_XB = 267 * MiB;
constexpr size_t WS_Z6 = 331 * MiB;
constexpr size_t WS_G = 523 * MiB;
constexpr size_t WS_H = 331 * MiB;
constexpr size_t WS_M32 = 331 * MiB;
constexpr size_t WS_MERGED = 395 * MiB;
constexpr size_t WS_PP = 715 * MiB;
constexpr size_t WS_P3 = 747 * MiB;
constexpr size_t WS_STATS = 843 * MiB;
constexpr size_t WS_NATB = 844 * MiB;
constexpr size_t WS_RF = 619 * MiB;
constexpr size_t WS_END = 846 * MiB;
static_assert(WS_G + (size_t)(CH / 256) * 24 * 65536 <= WS_RF && WS_RF + (size_t)CH * DM * 4 <= WS_P3 && WS_H + (size_t)CH * DFF * 2 <= WS_RF, "workspace map: the 8-bit gates end below the fragment-order residual, which ends below the mixer outputs; h stays below it too");
constexpr size_t CS_OFF = 262144; constexpr int CS_WIN_G = 0, CS_WIN_B = DIN, CS_WUP_G = 2 * DIN, CS_WUP_B = 2 * DIN + 2 * DFF;
constexpr size_t ZSTRIDE = (size_t)CH * 1024;
constexpr int CW_BAR = 4096;

constexpr int RING_OFF = 0, RING_BYTES = 131072;
constexpr int NA_KPITCH = 144, NA_RPITCH = 64 * NA_KPITCH + 16, NA_BAND = 8 * NA_RPITCH;
constexpr int STATS_OFF = 148480;
constexpr int MISC_OFF = STATS_OFF + 2048;
constexpr int LDS_BYTES = 151552;
static_assert(2 * NA_BAND <= STATS_OFF && RING_BYTES <= STATS_OFF, "LDS map");

#define GAS __attribute__((address_space(1)))
#define LAS __attribute__((address_space(3)))
typedef unsigned short bf16;
typedef unsigned v4u __attribute__((ext_vector_type(4)));
typedef unsigned v2u __attribute__((ext_vector_type(2)));
typedef float f32x4 __attribute__((ext_vector_type(4)));
typedef GAS unsigned gu32;
#define RLX_AGENT __ATOMIC_RELAXED, __HIP_MEMORY_SCOPE_AGENT
#define LDS_WAIT() asm volatile("s_waitcnt lgkmcnt(0)" ::: "memory")
__device__ __forceinline__ unsigned f2bf(float f) { unsigned u = __builtin_bit_cast(unsigned, f); return (u + 0x7fffu + ((u >> 16) & 1u)) >> 16; }
__device__ __forceinline__ unsigned pk2(float lo, float hi) { return f2bf(lo) | (f2bf(hi) << 16); }
__device__ __forceinline__ float bflo(unsigned w) { return __uint_as_float(w << 16); }
__device__ __forceinline__ float bfhi(unsigned w) { return __uint_as_float(w & 0xffff0000u); }

#define XB_TMO      128
#define XB_XCNT(j)  (256  + 64 * (j))
#define XB_XSUB(j)  (1280 + 64 * (j))
#define XB_XGEN(j)  (2304 + 64 * (j))
#define XB_TOP      3328
#define XB_TOPGEN   3392
#define XCD_BAR_WORDS 3456
#define XB_SPIN_CAP (1u << 18)

__device__ __forceinline__ unsigned xb_ld(unsigned* p)              { return __hip_atomic_load(p, __ATOMIC_RELAXED, __HIP_MEMORY_SCOPE_AGENT); }
__device__ __forceinline__ unsigned xb_add(unsigned* p, unsigned v) { return __hip_atomic_fetch_add(p, v, __ATOMIC_RELAXED, __HIP_MEMORY_SCOPE_AGENT); }
__device__ __forceinline__ unsigned xb_xcc_id() { return (unsigned)__builtin_amdgcn_s_getreg((3 << 11) | 20) & 0xFu; }
#define XB_SPIN(cond, bar) do { unsigned _sp = 0; while (cond) { __builtin_amdgcn_s_sleep(1); \
    if ((++_sp & 255u) == 0u) { if (xb_ld(&(bar)[XB_TMO])) break; if (_sp > XB_SPIN_CAP) { atomicAdd(&(bar)[XB_TMO], 1u); break; } } } } while (0)

struct XcdBarrier {
    unsigned* bar; unsigned x;
    volatile LAS unsigned* st;
};
__device__ __forceinline__ XcdBarrier xcd_barrier_post(unsigned* bar, volatile LAS unsigned* st) {
    XcdBarrier b; b.bar = bar; b.x = (unsigned)__builtin_amdgcn_readfirstlane((int)xb_xcc_id()); b.st = st;
    if (threadIdx.x == 0) (void)xb_add(&bar[XB_XCNT(b.x)], 1u);
    return b;
}
__device__ __forceinline__ void xcd_barrier_complete(unsigned* bar, unsigned x, unsigned& nloc, unsigned& nx) {
    const unsigned G = gridDim.x * gridDim.y * gridDim.z;
    unsigned sum, cnt, mine, sp = 0u;
    for (;;) {
        sum = 0u; cnt = 0u; mine = 0u;
#pragma unroll
        for (unsigned j = 0; j < 16; ++j) { const unsigned c = xb_ld(&bar[XB_XCNT(j)]); sum += c; cnt += (c > 0u) ? 1u : 0u; mine = (j == x) ? c : mine; }
        if (sum == G) break;
        __builtin_amdgcn_s_sleep(1);
        if ((++sp & 255u) == 0u) { if (xb_ld(&bar[XB_TMO])) break; if (sp > XB_SPIN_CAP) { atomicAdd(&bar[XB_TMO], 1u); break; } }
    }
    nloc = mine > 0u ? mine : 1u; nx = cnt > 0u ? cnt : 1u;
}
__device__ __forceinline__ void xcd_barrier(const XcdBarrier& b) {
    asm volatile("s_waitcnt vmcnt(0)" ::: "memory");
    __syncthreads();
    if (threadIdx.x == 0) {
        unsigned* bar = b.bar; unsigned bxcc = b.x;
        asm volatile("" : "+s"(bar), "+s"(bxcc));
        __builtin_amdgcn_s_waitcnt(0);
        unsigned nloc = b.st[0], nx = b.st[1];
        if (nloc == 0u) { xcd_barrier_complete(bar, bxcc, nloc, nx); b.st[0] = nloc; b.st[1] = nx; }
        const unsigned old = xb_add(&bar[XB_XSUB(bxcc)], 1u);
        const unsigned gen = old / nloc;
        if (old + 1u == (gen + 1u) * nloc) {
            __builtin_amdgcn_fence(__ATOMIC_RELEASE, "agent");
            asm volatile("s_waitcnt vmcnt(0)" ::: "memory");
            const unsigned og = xb_add(&bar[XB_TOP], 1u);
            const unsigned tg = og / nx;
            if (og + 1u == (tg + 1u) * nx) xb_add(&bar[XB_TOPGEN], 1u);
            else XB_SPIN(xb_ld(&bar[XB_TOPGEN]) == tg, bar);
            __builtin_amdgcn_fence(__ATOMIC_ACQUIRE, "agent");
            xb_add(&bar[XB_XGEN(bxcc)], 1u);
            asm volatile("s_waitcnt vmcnt(0)" ::: "memory");
        } else {
            XB_SPIN(xb_ld(&bar[XB_XGEN(bxcc)]) == gen, bar);
            __builtin_amdgcn_fence(__ATOMIC_ACQUIRE, "agent");
            asm volatile("s_waitcnt vmcnt(0)" ::: "memory");
        }
    }
    __syncthreads();
}

__device__ __forceinline__ float wave_sum(float v) {
#pragma unroll
    for (int o = 1; o < 64; o <<= 1) v += __shfl_xor(v, o);
    return v;
}

namespace pg8 {
#define PG8_ROWOFF(ai, m) ({ int _ro = (ai) * HALF + (m) * 16; asm volatile("" : "+s"(_ro)); _ro; })
#define PG8_PAIR_FENCE(m) do { if ((m) & 1) asm volatile("" ::: "memory"); } while (0)
__device__ __forceinline__ float sigmoidf_fast(float x) { return __builtin_amdgcn_rcpf(1.0f + __builtin_amdgcn_exp2f(-1.4426950408889634f * x)); }
__device__ __forceinline__ u32x4 pack8(const f32x4& v0, const f32x4& v1) { u32x4 w; w.x = cvt_pk_bf16(v0[0], v0[1]); w.y = cvt_pk_bf16(v0[2], v0[3]); w.z = cvt_pk_bf16(v1[0], v1[1]); w.w = cvt_pk_bf16(v1[2], v1[3]); return w; }
__device__ __forceinline__ unsigned q8x4(const f32x4& v) { unsigned r = 0u;
    r = __builtin_amdgcn_cvt_pk_u8_f32(__builtin_floorf(v[0] * 255.f + 0.5f), 0, r); r = __builtin_amdgcn_cvt_pk_u8_f32(__builtin_floorf(v[1] * 255.f + 0.5f), 1, r);
    r = __builtin_amdgcn_cvt_pk_u8_f32(__builtin_floorf(v[2] * 255.f + 0.5f), 2, r); r = __builtin_amdgcn_cvt_pk_u8_f32(__builtin_floorf(v[3] * 255.f + 0.5f), 3, r); return r; }
__device__ __forceinline__ f32x4 u8x4_f32(unsigned w) { return (f32x4){(float)(w & 0xffu), (float)((w >> 8) & 0xffu), (float)((w >> 16) & 0xffu), (float)(w >> 24)}; }
__device__ __forceinline__ void row_stats(const float* st, int row, float& mu, float& rs) { const f32x2 sv = *(const f32x2*)(st + 2 * (size_t)row); mu = sv.x * (1.f / DM); rs = rsqrtf(fmaxf(sv.y * (1.f / DM) - mu * mu, 0.f) + LN_EPS); }
struct LnFold {
    const float* st; const float* gw; const float* bw;
    struct Regs { float mu[8], rs[8]; f32x4 g[2][2], b[2][2]; };
    __device__ __forceinline__ void load(Regs& R, int row0, int gcol0) const {
        if (st) {
#pragma unroll
            for (int k = 0; k < 8; ++k) row_stats(st, row0 + (k >> 2) * HALF + (k & 3) * 16, R.mu[k], R.rs[k]);
#pragma unroll
            for (int bj = 0; bj < 2; ++bj)
#pragma unroll
                for (int n = 0; n < 2; ++n) { R.g[bj][n] = *(const f32x4*)(gw + gcol0 + bj * HALF + 4 * n); R.b[bj][n] = *(const f32x4*)(bw + gcol0 + bj * HALF + 4 * n); }
        }
    }
    __device__ __forceinline__ void apply(const Regs& R, f32x4& v0, f32x4& v1, int k, int bj) const {
        if (st) { v0 = (v0 - R.g[bj][0] * R.mu[k]) * R.rs[k] + R.b[bj][0]; v1 = (v1 - R.g[bj][1] * R.mu[k]) * R.rs[k] + R.b[bj][1]; } }
};
struct EpiZ {
    static constexpr bool PERM = true; static constexpr bool CHAIN = false;
    bf16_t* Z6; bf16_t* G; LnFold F;
    __device__ __forceinline__ void operator()(const f32x4 (&acc)[2][2][4][2], const Unit& u, int wr, int wc, int fr, int fq) const {
        bf16_t* base; int ldc, colt, act; float sc = 1.f;
        const int row0 = u.pm * BM + wr * 64 + fr, gcol0 = u.pn * BM + wc * 32 + 8 * fq;
        if (u.pn < 24) { const int t = u.pn >> 2; base = Z6 + (size_t)t * ZSTRIDE; ldc = 1024; colt = (u.pn & 3) * BM; act = (t == 1 || t == 2) ? 1 : 0; if (t == 3) sc = 0.125f; }
        else { base = G; ldc = 6144; colt = (u.pn - 24) * BM; act = 2; }
        bf16_t* const p0 = base + (size_t)row0 * ldc + colt + wc * 32 + 8 * fq;
        unsigned char* const gfrag = (unsigned char*)G + ((size_t)(u.pm * 24 + (u.pn - 24)) * 16 * 512 + ((((wr * 4 + wc) << 6) | (fq << 4) | fr))) * 8;
        LnFold::Regs R; F.load(R, row0, gcol0);
#pragma unroll
        for (int ai = 0; ai < 2; ++ai)
#pragma unroll
            for (int m = 0; m < 4; ++m) { const int ro = PG8_ROWOFF(ai, m); bf16_t* rowp = p0 + (size_t)ro * ldc;
#pragma unroll
                for (int bj = 0; bj < 2; ++bj) { f32x4 v0 = acc[ai][bj][m][0], v1 = acc[ai][bj][m][1];
                    F.apply(R, v0, v1, ai * 4 + m, bj);
                    if (act != 0) {
#pragma unroll
                        for (int j = 0; j < 4; ++j) { const float x = v0[j], y = v1[j];
                            const float sx = (act == 1) ? 1.5957691216057308f * (x + 0.044715f * x * x * x) : x, sy = (act == 1) ? 1.5957691216057308f * (y + 0.044715f * y * y * y) : y;
                            const float gx = sigmoidf_fast(sx), gy = sigmoidf_fast(sy); v0[j] = (act == 1) ? x * gx : gx; v1[j] = (act == 1) ? y * gy : gy; } }
                    if (act == 2) *(u32x2*)(gfrag + ((size_t)(((ro >> 3) - (ro >> 7) * 8 + bj) * 512)) * 8) = (u32x2){q8x4(v0), q8x4(v1)};
                    else *(u32x4*)(rowp + bj * HALF) = pack8(v0 * sc, v1 * sc); }
                PG8_PAIR_FENCE(m); }
    }
};
struct EpiPool {
    static constexpr bool PERM = true; static constexpr bool CHAIN = false;
    bf16_t* O; const float* sp;
    __device__ __forceinline__ void operator()(const f32x4 (&acc)[2][2][4][2], const Unit& u, int wr, int wc, int fr, int fq) const {
        const int col0 = u.pn * BM + wc * 32 + 8 * fq;
        bf16_t* const p0 = O + (size_t)(u.pm * BM + wr * 64 + fr) * 1024 + col0;
        f32x4 sv[2][2];
#pragma unroll
        for (int bj = 0; bj < 2; ++bj)
#pragma unroll
            for (int n = 0; n < 2; ++n) sv[bj][n] = *(const f32x4*)(sp + col0 + bj * HALF + 4 * n);
#pragma unroll
        for (int ai = 0; ai < 2; ++ai)
#pragma unroll
            for (int m = 0; m < 4; ++m) { bf16_t* rowp = p0 + (size_t)PG8_ROWOFF(ai, m) * 1024;
#pragma unroll
                for (int bj = 0; bj < 2; ++bj) *(u32x4*)(rowp + bj * HALF) = pack8(acc[ai][bj][m][0] * sv[bj][0], acc[ai][bj][m][1] * sv[bj][1]);
                PG8_PAIR_FENCE(m); }
    }
};
struct EpiGate {
    static constexpr bool PERM = true; static constexpr bool CHAIN = true;
    const bf16_t* G; bf16_t* MG;
    static __device__ __forceinline__ f32x4 floor4(f32x4 v) { return (f32x4){fmaxf(v[0], 1.0e-18f), fmaxf(v[1], 1.0e-18f), fmaxf(v[2], 1.0e-18f), fmaxf(v[3], 1.0e-18f)}; }
    static __device__ __forceinline__ f32x4 rcp4(f32x4 v) { return (f32x4){__builtin_amdgcn_rcpf(v[0]), __builtin_amdgcn_rcpf(v[1]), __builtin_amdgcn_rcpf(v[2]), __builtin_amdgcn_rcpf(v[3])}; }
    __device__ __forceinline__ void operator()(f32x4 (&acc)[2][2][4][2], const Unit& u, int wr, int wc, int fr, int fq) const {
        const int col0 = u.pn * BM + wc * 32 + 8 * fq; const size_t row0 = (size_t)(u.pm * BM + wr * 64 + fr);
        bf16_t* const m0 = MG + row0 * 2048 + col0;
        const unsigned char* const g0 = (const unsigned char*)G + ((size_t)(u.pm * 24 + u.br * 8 + u.pn) * 16 * 512 + ((((wr * 4 + wc) << 6) | (fq << 4) | fr))) * 8;
#pragma unroll
        for (int ai = 0; ai < 2; ++ai) {
            int ro[4]; u32x2 ga[4][2], gb[4][2];
#pragma unroll
            for (int m = 0; m < 4; ++m) { ro[m] = PG8_ROWOFF(ai, m);
#pragma unroll
                for (int bj = 0; bj < 2; ++bj) { const size_t so = (size_t)(((ro[m] >> 3) - (ro[m] >> 7) * 8 + bj) * 512) * 8;
                    ga[m][bj] = *(const u32x2*)(g0 + so);
                    if (u.br < 2) gb[m][bj] = *(const u32x2*)(g0 + so + (size_t)8 * 16 * 512 * 8); } }
#pragma unroll
            for (int m = 0; m < 4; ++m)
#pragma unroll
                for (int bj = 0; bj < 2; ++bj) {
                    f32x4 a0 = u8x4_f32(ga[m][bj].x), a1 = u8x4_f32(ga[m][bj].y);
                    if (u.br > 0) { a0 = floor4(a0); a1 = floor4(a1); }
                    if (u.br < 2) { const f32x4 b0 = floor4(u8x4_f32(gb[m][bj].x)), b1 = floor4(u8x4_f32(gb[m][bj].y));
                        acc[ai][bj][m][0] = acc[ai][bj][m][0] * (a0 * rcp4(b0)); acc[ai][bj][m][1] = acc[ai][bj][m][1] * (a1 * rcp4(b1)); }
                    else *(u32x4*)(m0 + (size_t)ro[m] * 2048 + bj * HALF) = pack8(acc[ai][bj][m][0] * (a0 * (1.f / 255.f)), acc[ai][bj][m][1] * (a1 * (1.f / 255.f))); }
            asm volatile("" ::: "memory"); }
    }
};
struct EpiResLn {
    static constexpr bool PERM = true; static constexpr bool CHAIN = false;
    const float* in32; float* out32; bf16_t* lof; bf16_t* xb; const float* st_in; const float* g_in; const float* b_in; float* st_out;
    static __device__ __forceinline__ f32x4 lo4(const u32x4& w) { return (f32x4){bf_lo(w.x), bf_hi(w.x), bf_lo(w.y), bf_hi(w.y)}; }
    static __device__ __forceinline__ f32x4 hi4(const u32x4& w) { return (f32x4){bf_lo(w.z), bf_hi(w.z), bf_lo(w.w), bf_hi(w.w)}; }
    __device__ __forceinline__ void operator()(const f32x4 (&acc)[2][2][4][2], const Unit& u, int wr, int wc, int fr, int fq) const {
        const int row0 = u.pm * BM + wr * 64 + fr, col0 = u.pn * BM + wc * 32 + 8 * fq;
        const size_t off0 = (size_t)row0 * 2048 + col0;
        bf16_t* const f0 = lof + (size_t)(u.pm * 8 + u.pn) * 65536 + (size_t)((((wr * 4 + wc) << 6) | (fq << 4) | fr)) * 8;
        f32x4 gv[2][2], bv[2][2];
        if (st_in) {
#pragma unroll
            for (int bj = 0; bj < 2; ++bj)
#pragma unroll
                for (int n = 0; n < 2; ++n) { gv[bj][n] = *(const f32x4*)(g_in + col0 + bj * HALF + 4 * n); bv[bj][n] = *(const f32x4*)(b_in + col0 + bj * HALF + 4 * n); }
        }
#define PG8_RES_BATCH(AI, M0, NB) do { int ro[NB]; f32x4 r[NB][2][2]; f32x2 sv[NB]; \
            _Pragma("unroll") for (int mm = 0; mm < NB; ++mm) { ro[mm] = PG8_ROWOFF(AI, (M0) + mm); \
                if (st_in) sv[mm] = *(const f32x2*)(st_in + 2 * (size_t)(row0 + ro[mm])); \
                _Pragma("unroll") for (int bj = 0; bj < 2; ++bj) { \
                    if (in32) { r[mm][bj][0] = *(const f32x4*)(in32 + off0 + (size_t)ro[mm] * 2048 + bj * HALF); r[mm][bj][1] = *(const f32x4*)(in32 + off0 + (size_t)ro[mm] * 2048 + bj * HALF + 4); } \
                    else { r[mm][bj][0] = *(const f32x4*)(const void*)(xb + off0 + (size_t)ro[mm] * 2048 + bj * HALF); \
                           r[mm][bj][1] = *(const f32x4*)(const void*)(f0 + (size_t)(((ro[mm] >> 3) - (ro[mm] >> 7) * 8 + bj) * 4096)); } } } \
            _Pragma("unroll") for (int mm = 0; mm < NB; ++mm) { const int m = (M0) + mm; float ps = 0.f, pq = 0.f, mu = 0.f, rs = 1.f; \
                if (st_in) { mu = sv[mm].x * (1.f / DM); rs = rsqrtf(fmaxf(sv[mm].y * (1.f / DM) - mu * mu, 0.f) + LN_EPS); } \
                _Pragma("unroll") for (int bj = 0; bj < 2; ++bj) { f32x4 x[2], o[2]; \
                    if (in32) { x[0] = r[mm][bj][0]; x[1] = r[mm][bj][1]; } \
                    else { const u32x4 hq = __builtin_bit_cast(u32x4, r[mm][bj][0]), lq = __builtin_bit_cast(u32x4, r[mm][bj][1]); x[0] = lo4(hq) + lo4(lq); x[1] = hi4(hq) + hi4(lq); } \
                    _Pragma("unroll") for (int n = 0; n < 2; ++n) { \
                        if (st_in) x[n] = (x[n] - mu) * rs * gv[bj][n] + bv[bj][n]; \
                        o[n] = x[n] * DN_ALPHA + acc[AI][bj][m][n]; \
                        if (out32) *(f32x4*)(out32 + off0 + (size_t)ro[mm] * 2048 + bj * HALF + 4 * n) = o[n]; \
                        ps += (o[n][0] + o[n][1]) + (o[n][2] + o[n][3]); pq += (o[n][0] * o[n][0] + o[n][1] * o[n][1]) + (o[n][2] * o[n][2] + o[n][3] * o[n][3]); } \
                    if (!out32) { const u32x4 wh = pack8(o[0], o[1]); const u32x4 wl = pack8(o[0] - lo4(wh), o[1] - hi4(wh)); \
                        *(u32x4*)(xb + off0 + (size_t)ro[mm] * 2048 + bj * HALF) = wh; \
                        *(u32x4*)(f0 + (size_t)(((ro[mm] >> 3) - (ro[mm] >> 7) * 8 + bj) * 4096)) = wl; } } \
                if (st_out) { ps += __shfl_xor(ps, 16); ps += __shfl_xor(ps, 32); pq += __shfl_xor(pq, 16); pq += __shfl_xor(pq, 32); \
                    if (fq == 0) { float* sp = st_out + 2 * (size_t)(row0 + ro[mm]); __hip_atomic_fetch_add(sp, ps, __ATOMIC_RELAXED, __HIP_MEMORY_SCOPE_AGENT); __hip_atomic_fetch_add(sp + 1, pq, __ATOMIC_RELAXED, __HIP_MEMORY_SCOPE_AGENT); } } } \
            asm volatile("" ::: "memory"); } while (0)
        PG8_RES_BATCH(0, 0, 1); PG8_RES_BATCH(0, 1, 1); PG8_RES_BATCH(0, 2, 2); PG8_RES_BATCH(1, 0, 2); PG8_RES_BATCH(1, 2, 2);
#undef PG8_RES_BATCH
    }
};
struct EpiSq {
    static constexpr bool PERM = true; static constexpr bool CHAIN = false;
    bf16_t* O; LnFold F;
    __device__ __forceinline__ void operator()(const f32x4 (&acc)[2][2][4][2], const Unit& u, int wr, int wc, int fr, int fq) const {
        const int row0 = u.pm * BM + wr * 64 + fr, gcol0 = u.pn * BM + wc * 32 + 8 * fq;
        bf16_t* const p0 = O + (size_t)row0 * DFF + gcol0;
        LnFold::Regs R; F.load(R, row0, gcol0);
#pragma unroll
        for (int ai = 0; ai < 2; ++ai)
#pragma unroll
            for (int m = 0; m < 4; ++m) { bf16_t* rowp = p0 + (size_t)PG8_ROWOFF(ai, m) * DFF;
#pragma unroll
                for (int bj = 0; bj < 2; ++bj) { f32x4 v0 = acc[ai][bj][m][0], v1 = acc[ai][bj][m][1];
                    F.apply(R, v0, v1, ai * 4 + m, bj);
#pragma unroll
                    for (int j = 0; j < 4; ++j) { const float a = fmaxf(v0[j], 0.f), b = fmaxf(v1[j], 0.f); v0[j] = a * a; v1[j] = b * b; }
                    *(u32x4*)(rowp + bj * HALF) = pack8(v0, v1); }
                PG8_PAIR_FENCE(m); }
    }
};
}

struct Args { const float* in[20]; float* out; unsigned char* ws; };
#define CAS __attribute__((address_space(4)))
__device__ __forceinline__ const CAS char* kernarg_base() { const CAS char* ka = (const CAS char*)__builtin_amdgcn_kernarg_segment_ptr(); asm volatile("" : "+s"(ka)); return ka; }
__device__ __forceinline__ const float* arg_in(int i) { return (const float*)*(const __attribute__((address_space(1))) float* const CAS*)(kernarg_base() + 8 * i); }
__device__ __forceinline__ float* arg_out() { return (float*)*(__attribute__((address_space(1))) float* const CAS*)(kernarg_base() + 8 * 20); }
__device__ __forceinline__ unsigned char* arg_ws() { return (unsigned char*)*(__attribute__((address_space(1))) unsigned char* const CAS*)(kernarg_base() + 8 * 21); }
enum { I_XP = 0, I_XS, I_WIN, I_WPOOL, I_SPOOL, I_SLNG, I_SLNB, I_WS, I_BS, I_RPB, I_WBRP, I_WBRS, I_WBRN, I_WOUT, I_LN1G, I_LN1B, I_WUP, I_WDN, I_LN2G, I_LN2B };

__device__ __forceinline__ void transpose_item(const float* W, int K, int N, bf16* WT, LAS float* scr, int item, int lane, const float* gk, const float* bk, float* csg, float* csb) {
    const int nblk = N / 32, kb = item / nblk, nb = item % nblk, k0 = 64 * kb, n0 = 32 * nb;
    float wv[32];
#pragma unroll
    for (int i = 0; i < 32; ++i) wv[i] = W[(size_t)(k0 + 2 * i + (lane >> 5)) * N + n0 + (lane & 31)];
#pragma unroll
    for (int i = 0; i < 32; ++i) scr[(2 * i + (lane >> 5)) * 33 + (lane & 31)] = wv[i];
    LDS_WAIT(); asm volatile("" ::: "memory");
    const int c = lane & 7;
    f32x4 ga = (f32x4){1.f, 1.f, 1.f, 1.f}, gb = ga;
    if (gk) {
        ga = *(const GAS f32x4*)(gk + k0 + 8 * c); gb = *(const GAS f32x4*)(gk + k0 + 8 * c + 4);
        const int n = lane & 31, hf = lane >> 5; const float* vec = hf ? bk : gk; float s = 0.f;
        for (int kk = 0; kk < 64; ++kk) { const float p = vec[k0 + kk] * scr[kk * 33 + n]; s += hf ? p : __uint_as_float(f2bf(p) << 16); }
        __hip_atomic_fetch_add((hf ? csb : csg) + n0 + n, s, __ATOMIC_RELAXED, __HIP_MEMORY_SCOPE_AGENT);
    }
#pragma unroll
    for (int j = 0; j < 4; ++j) { const int n = (lane >> 3) + 8 * j; const LAS float* s = scr + (8 * c) * 33 + n;
        v4u o; o.x = pk2(s[0 * 33] * ga.x, s[1 * 33] * ga.y); o.y = pk2(s[2 * 33] * ga.z, s[3 * 33] * ga.w); o.z = pk2(s[4 * 33] * gb.x, s[5 * 33] * gb.y); o.w = pk2(s[6 * 33] * gb.z, s[7 * 33] * gb.w);
        *(GAS v4u*)(WT + (size_t)(n0 + n) * K + k0 + 8 * c) = o; }
    LDS_WAIT(); asm volatile("" ::: "memory");
}

__device__ __forceinline__ void ln_row(float* row, bf16* xb, const float* g, const float* b, int lane) {
    GAS f32x4* xr = (GAS f32x4*)row + lane;
    f32x4 v[8]; float s = 0.f;
#pragma unroll
    for (int j = 0; j < 8; ++j) { v[j] = xr[64 * j]; s += (v[j].x + v[j].y) + (v[j].z + v[j].w); }
    const float mean = wave_sum(s) * (1.f / DM); float s2 = 0.f;
#pragma unroll
    for (int j = 0; j < 8; ++j) { v[j] = v[j] - mean; s2 += (v[j].x * v[j].x + v[j].y * v[j].y) + (v[j].z * v[j].z + v[j].w * v[j].w); }
    const float rstd = 1.f / sqrtf(wave_sum(s2) * (1.f / DM) + LN_EPS);
    const GAS f32x4* gp = (const GAS f32x4*)g + lane; const GAS f32x4* bp = (const GAS f32x4*)b + lane;
#pragma unroll
    for (int j = 0; j < 8; ++j) { const f32x4 y = v[j] * rstd * gp[64 * j] + bp[64 * j]; xr[64 * j] = y;
        if (xb) { v2u o; o.x = pk2(y.x, y.y); o.y = pk2(y.z, y.w); *((GAS v2u*)xb + lane + 64 * j) = o; } }
}

template <int HW> __device__ __forceinline__ void pool_quad(const bf16* zp, LAS unsigned char* dst, int pitch, int pos0, int seqlen) {
    constexpr int NR = 2 * HW + 3;
    v4u w[NR];
#pragma unroll
    for (int i = 0; i < NR; ++i) { const int d = i - HW, t = pos0 + d; const bool ok = (t >= 0) && (t < seqlen);
        v4u z; z.x = 0u; z.y = 0u; z.z = 0u; z.w = 0u; if (ok) z = *(const GAS v4u*)(zp + (ptrdiff_t)d * 1024); w[i] = z; }
    float s[8] = {0.f, 0.f, 0.f, 0.f, 0.f, 0.f, 0.f, 0.f};
#pragma unroll
    for (int i = 0; i < 2 * HW; ++i) { s[0] += bflo(w[i].x); s[1] += bfhi(w[i].x); s[2] += bflo(w[i].y); s[3] += bfhi(w[i].y); s[4] += bflo(w[i].z); s[5] += bfhi(w[i].z); s[6] += bflo(w[i].w); s[7] += bfhi(w[i].w); }
#pragma unroll
    for (int k = 0; k < 4; ++k) {
        if (k > 0) { const v4u a = w[2 * HW + k - 1], b = w[k - 1];
            s[0] += bflo(a.x) - bflo(b.x); s[1] += bfhi(a.x) - bfhi(b.x); s[2] += bflo(a.y) - bflo(b.y); s[3] += bfhi(a.y) - bfhi(b.y);
            s[4] += bflo(a.z) - bflo(b.z); s[5] += bfhi(a.z) - bfhi(b.z); s[6] += bflo(a.w) - bflo(b.w); s[7] += bfhi(a.w) - bfhi(b.w); }
        const int pos = pos0 + k; const float inv = 1.0f / (float)(min(pos + HW, seqlen) - max(pos - HW, 0)); const v4u c = w[HW + k];
        v4u o; o.x = pk2(s[0] * inv - bflo(c.x), s[1] * inv - bfhi(c.x)); o.y = pk2(s[2] * inv - bflo(c.y), s[3] * inv - bfhi(c.y));
        o.z = pk2(s[4] * inv - bflo(c.z), s[5] * inv - bfhi(c.z)); o.w = pk2(s[6] * inv - bflo(c.w), s[7] * inv - bfhi(c.w));
        *(LAS v4u*)(dst + k * pitch) = o; }
}

#define WSP(T, off) ((T*)(arg_ws() + (off)))
__device__ __forceinline__ const float* chunk_x0(int c) { return (c * CH < PROMPT_ROWS) ? arg_in(I_XP) + (size_t)c * CH * DM : arg_in(I_XS) + ((size_t)c * CH - PROMPT_ROWS) * DM; }
__device__ __forceinline__ float* chunk_R(int c) { return arg_out() + (size_t)c * CH * DM; }

__global__ void __launch_bounds__(512, 2) fwd_kernel(Args args) {
    extern __shared__ __attribute__((aligned(16))) unsigned char lds_raw[];
    LAS unsigned char* lds = (LAS unsigned char*)lds_raw;
    volatile LAS unsigned* MISC = (volatile LAS unsigned*)(lds + MISC_OFF);
    const int tid0 = threadIdx.x;
#define FRESH_TID() int tid = tid0; asm volatile("" : "+v"(tid)); const int lane = tid & 63, wave = __builtin_amdgcn_readfirstlane(tid >> 6); const int gw = bx * 8 + wave, gt = bx * 512 + tid; (void)lane; (void)gw; (void)gt
    const int G = gridDim.x, bx = blockIdx.x;
    for (int u = tid0; u < (LDS_BYTES - MISC_OFF) / 4; u += 512) ((LAS unsigned*)(lds + MISC_OFF))[u] = 0u;
    __syncthreads();
    XcdBarrier bar = xcd_barrier_post((unsigned*)(args.ws + WS_CTL) + CW_BAR, MISC + 8);
#define GRID_BAR() xcd_barrier(bar)
    const int NGW = G * 8, NGT = G * 512;

    {
                FRESH_TID();
        LAS float* scr = (LAS float*)(lds + RING_OFF + wave * 16384);
        constexpr int IT_IN = (DM / 64) * (DIN / 32), IT_BR = (1024 / 64) * (DM / 32), IT_OUT = (DM / 64) * (DM / 32), IT_UP = (DM / 64) * (DFF / 32), IT_DN = (DFF / 64) * (DM / 32), IT_PL = (256 / 64) * (256 / 32);
        constexpr int IT_LAYER = IT_IN + 3 * IT_BR + IT_OUT + IT_UP + IT_DN + 4 * IT_PL;
        for (int it = gw; it < DEPTH * IT_LAYER; it += NGW) {
            const int l = it / IT_LAYER; int r = it % IT_LAYER;
            if (r < IT_IN) { float* cs = WSP(float, WS_CTL + CS_OFF);
                transpose_item(arg_in(I_WIN) + (size_t)l * DM * DIN, DM, DIN, WSP(bf16, WS_WIN) + (size_t)l * DIN * DM, scr, r, lane, l ? arg_in(I_LN2G) : (const float*)nullptr, l ? arg_in(I_LN2B) : (const float*)nullptr, cs + CS_WIN_G, cs + CS_WIN_B); continue; } r -= IT_IN;
            if (r < 3 * IT_BR) { const int b = r / IT_BR; transpose_item(arg_in(I_WBRP + b) + (size_t)l * 1024 * DM, 1024, DM, WSP(bf16, WS_WBR) + (size_t)(l * 3 + b) * DM * 1024, scr, r % IT_BR, lane, nullptr, nullptr, nullptr, nullptr); continue; } r -= 3 * IT_BR;
            if (r < IT_OUT) { transpose_item(arg_in(I_WOUT) + (size_t)l * DM * DM, DM, DM, WSP(bf16, WS_WOUT) + (size_t)l * DM * DM, scr, r, lane, nullptr, nullptr, nullptr, nullptr); continue; } r -= IT_OUT;
            if (r < IT_UP) { float* cs = WSP(float, WS_CTL + CS_OFF);
                transpose_item(arg_in(I_WUP) + (size_t)l * DM * DFF, DM, DFF, WSP(bf16, WS_WUP) + (size_t)l * DFF * DM, scr, r, lane, arg_in(I_LN1G) + l * DM, arg_in(I_LN1B) + l * DM, cs + CS_WUP_G + l * DFF, cs + CS_WUP_B + l * DFF); continue; } r -= IT_UP;
            if (r < IT_DN) { transpose_item(arg_in(I_WDN) + (size_t)l * DFF * DM, DFF, DM, WSP(bf16, WS_WDN) + (size_t)l * DM * DFF, scr, r, lane, nullptr, nullptr, nullptr, nullptr); continue; } r -= IT_DN;
            { const int gI = r / IT_PL; transpose_item(arg_in(I_WPOOL) + (size_t)(l * 4 + gI) * 65536, 256, 256, WSP(bf16, WS_WPOOL) + (size_t)(l * 4 + gI) * 65536, scr, r % IT_PL, lane, nullptr, nullptr, nullptr, nullptr); }
        }
    }
    {
        FRESH_TID();
        const float* rpb = arg_in(I_RPB); bf16* tb = WSP(bf16, WS_NATB);
        for (int e = gt; e < DEPTH * NA_HEADS * 15 * 4 * 2 * 64; e += NGT) {
            const int ln = e & 63, ch = (e >> 6) & 1, jq = (e >> 7) & 3, rest = e >> 9, dr = rest % 15, lh = rest / 15;
            const int qc = 16 * jq + (ln & 15), c0 = min(max(qc - NA_KW / 2, 0), GRID_W - NA_KW), kc0 = (jq == 0) ? 0 : (jq == 1) ? 8 : (jq == 2) ? 24 : 32;
            float v[4];
#pragma unroll
            for (int i = 0; i < 4; ++i) { const int kc = kc0 + 16 * ch + 4 * (ln >> 4) + i; const bool ok = (unsigned)(kc - c0) < (unsigned)NA_KW; v[i] = ok ? rpb[(size_t)(lh * 15 + dr) * 31 + (kc - qc + NA_KW - 1)] : -1.0e30f; }
            v2u o; o.x = pk2(v[0], v[1]); o.y = pk2(v[2], v[3]); *((GAS v2u*)tb + e) = o;
        }
    }
    {
        FRESH_TID();
        const float* w = arg_in(I_WS); bf16* o = WSP(bf16, WS_WSB);
        for (int i = gt; i < DEPTH * 8 * 16384 / 4; i += NGT) { const f32x4 a = *((const GAS f32x4*)w + i); v2u p; p.x = pk2(a.x, a.y); p.y = pk2(a.z, a.w); *((GAS v2u*)o + i) = p; }
    }
    GRID_BAR();

    for (int c = 0; c < NCHUNK; ++c) {
        const int seqlen = (c * CH < PROMPT_ROWS) ? SEQ_P : SEQ_S;
        {
                FRESH_TID();
            const float* x0 = chunk_x0(c); bf16* XB = WSP(bf16, WS_XB);
            for (size_t i = gt; i < (size_t)CH * DM / 8; i += NGT) {
                const f32x4 a = *((const GAS f32x4*)x0 + 2 * i), b = *((const GAS f32x4*)x0 + 2 * i + 1);
                v4u o; o.x = pk2(a.x, a.y); o.y = pk2(a.z, a.w); o.z = pk2(b.x, b.y); o.w = pk2(b.z, b.w);
                *((GAS v4u*)XB + i) = o;
            }
            float* st = WSP(float, WS_STATS);
            float zf = 0.f; asm volatile("" : "+v"(zf));
            for (int i = gt; i < 4 * CH * 2 / 4; i += NGT) *((GAS f32x4*)st + i) = (f32x4){zf, zf, zf, zf};
        }
        GRID_BAR();
        for (int l = 0; l < DEPTH; ++l) {
            {
                pg8::Gemm g{WSP(bf16, WS_XB), WSP(bf16, WS_WIN) + (size_t)l * DIN * DM, DM, DM, DM, 0, 0, 0}; pg8::StaticOrder S; S.init(CH, DIN, G, bx);
                const float* cs = WSP(float, WS_CTL + CS_OFF);
                pg8::EpiZ E{WSP(bf16, WS_Z6), WSP(bf16, WS_G), pg8::LnFold{l ? WSP(float, WS_STATS) + 1 * CH * 2 : (const float*)nullptr, cs + CS_WIN_G, cs + CS_WIN_B}};
                pg8::gemm_phase<pg8::EpiZ, pg8::StaticOrder, PG8_ALIGN, PG8_SP2>(lds + RING_OFF, g, S, E);
            }
            GRID_BAR();
            {
                FRESH_TID();
                const bf16* Za = WSP(bf16, WS_Z6); bf16* PA = WSP(bf16, WS_P3);
                const bf16* wpt = WSP(bf16, WS_WPOOL) + (size_t)l * 4 * 65536; const float* spl = arg_in(I_SPOOL) + l * 1024;
                LAS unsigned char* PI = lds + RING_OFF; constexpr int PPITCH = 528;
                const int n = lane & 15, g4 = lane >> 4;
#pragma unroll 1
                for (int un = bx; un < (CH / 256) * 4; un += G) {
                    const int gI = un & 3, row0 = (un >> 2) * 256;
#pragma unroll 1
                    for (int it = 0; it < 4; ++it) {
                        const int idx = tid + 512 * it, qd = idx >> 5, j8 = idx & 31, lr0 = row0 + 4 * qd, pos0 = lr0 % seqlen;
                        const bf16* zp = Za + (size_t)lr0 * 1024 + gI * 256 + 8 * j8; LAS unsigned char* dp = PI + (4 * qd) * PPITCH + j8 * 16;
                        if (gI == 0) pool_quad<1>(zp, dp, PPITCH, pos0, seqlen); else if (gI == 1) pool_quad<2>(zp, dp, PPITCH, pos0, seqlen); else if (gI == 2) pool_quad<4>(zp, dp, PPITCH, pos0, seqlen); else pool_quad<8>(zp, dp, PPITCH, pos0, seqlen);
                    }
                    pg8::bf16x8 wf[2][8];
#pragma unroll
                    for (int nt = 0; nt < 2; ++nt)
#pragma unroll
                        for (int ks = 0; ks < 8; ++ks) wf[nt][ks] = *(const GAS pg8::bf16x8*)(wpt + (size_t)gI * 65536 + (size_t)(32 * wave + 16 * nt + n) * 256 + 32 * ks + 8 * g4);
                    f32x4 sp4[2];
#pragma unroll
                    for (int nt = 0; nt < 2; ++nt) sp4[nt] = *(const GAS f32x4*)(spl + gI * 256 + 32 * wave + 16 * nt + 4 * g4);
                    __syncthreads();
#pragma unroll 1
                    for (int mt = 0; mt < 16; ++mt) {
                        f32x4 acc[2] = {(f32x4){0.f, 0.f, 0.f, 0.f}, (f32x4){0.f, 0.f, 0.f, 0.f}};
                        const LAS unsigned char* pr = PI + (16 * mt + n) * PPITCH + g4 * 16;
#pragma unroll
                        for (int ks = 0; ks < 8; ++ks) { const pg8::bf16x8 pf = *(const LAS pg8::bf16x8*)(pr + ks * 64);
#pragma unroll
                            for (int nt = 0; nt < 2; ++nt) acc[nt] = __builtin_amdgcn_mfma_f32_16x16x32_bf16(wf[nt][ks], pf, acc[nt], 0, 0, 0); }
#pragma unroll
                        for (int nt = 0; nt < 2; ++nt) { v2u o; o.x = pk2(acc[nt][0] * sp4[nt].x, acc[nt][1] * sp4[nt].y); o.y = pk2(acc[nt][2] * sp4[nt].z, acc[nt][3] * sp4[nt].w);
                            *(GAS v2u*)(PA + (size_t)(row0 + 16 * mt + n) * 1024 + gI * 256 + 32 * wave + 16 * nt + 4 * g4) = o; }
                    }
                    __syncthreads();
                }
            }
            {
                FRESH_TID();
                const bf16* Zu = WSP(bf16, WS_Z6) + ZSTRIDE; const bf16* Zv = WSP(bf16, WS_Z6) + 2 * ZSTRIDE; bf16* PB = WSP(bf16, WS_P3) + ZSTRIDE;
                const float* lng = arg_in(I_SLNG) + l * 1024; const float* lnb = arg_in(I_SLNB) + l * 1024;
                const bf16* wsb = WSP(bf16, WS_WSB) + (size_t)l * 8 * 16384; const float* bsl = arg_in(I_BS) + l * 8 * 128;
                LAS unsigned char* VNI = lds + RING_OFF; LAS float* ST = (LAS float*)(lds + STATS_OFF);
                constexpr int VP = 1056;
                for (int un = bx; un < (CH / 128) * 2; un += G) {
                    const int nck = un >> 1, hq = un & 1, tok0 = nck * 128;
#pragma unroll 1
                    for (int th = 0; th < 2; ++th) {
                        v4u wv[8][2];
#pragma unroll
                        for (int tt = 0; tt < 8; ++tt) { const bf16* rp = Zv + (size_t)(tok0 + wave * 16 + th * 8 + tt) * 1024 + lane * 16; wv[tt][0] = *(const GAS v4u*)rp; wv[tt][1] = *(const GAS v4u*)(rp + 8); }
#pragma unroll
                        for (int tt = 0; tt < 8; ++tt) { const v4u w0 = wv[tt][0], w1 = wv[tt][1];
                            float x[16] = {bflo(w0.x), bfhi(w0.x), bflo(w0.y), bfhi(w0.y), bflo(w0.z), bfhi(w0.z), bflo(w0.w), bfhi(w0.w), bflo(w1.x), bfhi(w1.x), bflo(w1.y), bfhi(w1.y), bflo(w1.z), bfhi(w1.z), bflo(w1.w), bfhi(w1.w)};
                            float s = 0.f;
#pragma unroll
                            for (int j = 0; j < 16; ++j) s += x[j];
                            const float mean = wave_sum(s) * (1.f / 1024.f); float s2 = 0.f;
#pragma unroll
                            for (int j = 0; j < 16; ++j) { const float d = x[j] - mean; s2 += d * d; }
                            const float rstd = 1.f / sqrtf(wave_sum(s2) * (1.f / 1024.f) + LN_EPS);
                            if (lane == 0) { const int tk = wave * 16 + th * 8 + tt; ST[2 * tk] = mean; ST[2 * tk + 1] = rstd; } }
                    }
                    __syncthreads();
#pragma unroll 1
                    for (int ih = 0; ih < 2; ++ih) {
                        v4u wv[8];
#pragma unroll
                        for (int i = 0; i < 8; ++i) { const int idx = tid + 512 * (ih * 8 + i), q = idx >> 6, c8 = (idx & 63) * 8; wv[i] = *(const GAS v4u*)(Zv + (size_t)(tok0 + q) * 1024 + hq * 512 + c8); }
                        const int c8 = (tid & 63) * 8;
                        const f32x4 g0 = *(const GAS f32x4*)(lng + hq * 512 + c8), g1 = *(const GAS f32x4*)(lng + hq * 512 + c8 + 4), b0 = *(const GAS f32x4*)(lnb + hq * 512 + c8), b1 = *(const GAS f32x4*)(lnb + hq * 512 + c8 + 4);
#pragma unroll
                        for (int i = 0; i < 8; ++i) { const int idx = tid + 512 * (ih * 8 + i), q = idx >> 6; const v4u w = wv[i];
                            const float mean = ST[2 * q], rstd = ST[2 * q + 1];
                            v4u o; o.x = pk2((bflo(w.x) - mean) * rstd * g0.x + b0.x, (bfhi(w.x) - mean) * rstd * g0.y + b0.y); o.y = pk2((bflo(w.y) - mean) * rstd * g0.z + b0.z, (bfhi(w.y) - mean) * rstd * g0.w + b0.w);
                            o.z = pk2((bflo(w.z) - mean) * rstd * g1.x + b1.x, (bfhi(w.z) - mean) * rstd * g1.y + b1.y); o.w = pk2((bflo(w.w) - mean) * rstd * g1.z + b1.z, (bfhi(w.w) - mean) * rstd * g1.w + b1.w);
                            *(LAS v4u*)(VNI + q * VP + c8 * 2) = o; }
                    }
                    __syncthreads();
                    const int n = lane & 15, g4 = lane >> 4, p = wave * 16 + n;
                    const LAS unsigned char* ap = VNI + (8 * g4 + ((lane & 15) >> 2)) * VP + (lane & 3) * 8;
                    pg8::bf16x8 wfN[4]; v2u uN[8]; float bsN;
#define SGU_FETCH(GI) do { const int gI_ = hq * 4 + (GI); \
                        _Pragma("unroll") for (int ks = 0; ks < 4; ++ks) wfN[ks] = *(const GAS pg8::bf16x8*)(wsb + (size_t)gI_ * 16384 + p * 128 + 32 * ks + 8 * g4); \
                        _Pragma("unroll") for (int ct = 0; ct < 8; ++ct) uN[ct] = *(const GAS v2u*)(Zu + (size_t)(tok0 + p) * 1024 + gI_ * 128 + ct * 16 + 4 * g4); \
                        bsN = bsl[gI_ * 128 + p]; } while (0)
                    SGU_FETCH(0);
#pragma unroll 1
                    for (int gi = 0; gi < 4; ++gi) {
                        const int gI = hq * 4 + gi;
                        pg8::bf16x8 wf[4]; v2u uw[8];
#pragma unroll
                        for (int ks = 0; ks < 4; ++ks) wf[ks] = wfN[ks];
#pragma unroll
                        for (int ct = 0; ct < 8; ++ct) uw[ct] = uN[ct];
                        const float bsv = bsN;
                        SGU_FETCH(min(gi + 1, 3));
#pragma unroll
                        for (int ct = 0; ct < 8; ++ct) {
                            f32x4 acc = (f32x4){0.f, 0.f, 0.f, 0.f};
#pragma unroll
                            for (int ks = 0; ks < 4; ++ks) { const LAS unsigned char* a = ap + ks * 32 * VP + (gi * 128 + ct * 16) * 2;
                                typedef short v4s __attribute__((ext_vector_type(4)));
                                const v4s t0 = __builtin_amdgcn_ds_read_tr16_b64_v4i16((LAS v4s*)a), t1 = __builtin_amdgcn_ds_read_tr16_b64_v4i16((LAS v4s*)(a + 4 * VP));
                                const pg8::bf16x8 vf = __builtin_shufflevector(t0, t1, 0, 1, 2, 3, 4, 5, 6, 7);
                                acc = __builtin_amdgcn_mfma_f32_16x16x32_bf16(vf, wf[ks], acc, 0, 0, 0); }
                            const size_t off = (size_t)(tok0 + p) * 1024 + gI * 128 + ct * 16 + 4 * g4;
                            v2u o; o.x = pk2(bflo(uw[ct].x) * (acc[0] + bsv), bfhi(uw[ct].x) * (acc[1] + bsv)); o.y = pk2(bflo(uw[ct].y) * (acc[2] + bsv), bfhi(uw[ct].y) * (acc[3] + bsv));
                            *(GAS v2u*)(PB + off) = o;
                        }
                    }
#undef SGU_FETCH
                    __syncthreads();
                }
            }
            {
                FRESH_TID();
                const bf16* Qb = WSP(bf16, WS_Z6) + 3 * ZSTRIDE; const bf16* Kb = Qb + ZSTRIDE; const bf16* Vb = Kb + ZSTRIDE; bf16* PC = WSP(bf16, WS_P3) + 2 * ZSTRIDE;
                const bf16* tbl = WSP(bf16, WS_NATB) + (size_t)l * NA_HEADS * 15 * 4 * 2 * 256;
                const int rows = seqlen / GRID_W, NUN = (CH / GRID_W / 2) * NA_HEADS;
                LAS unsigned char* Ks = lds + RING_OFF; LAS unsigned char* Vs = lds + RING_OFF + 9 * 8192;
                const int n = lane & 15, g4 = lane >> 4, jq = wave & 3, rr = wave >> 2;
                const int kc0 = (jq == 0) ? 0 : (jq == 1) ? 8 : (jq == 2) ? 24 : 32;
                const int qcol = 16 * jq + n;
                int koff[2][2], voff[2][4];
#pragma unroll
                for (int ch = 0; ch < 2; ++ch)
#pragma unroll
                    for (int ks = 0; ks < 2; ++ks) { const int kc = kc0 + 16 * ch + n; koff[ch][ks] = kc * 128 + (((4 * ks + g4) ^ (kc & 7)) * 16); }
#pragma unroll
                for (int t1 = 0; t1 < 2; ++t1)
#pragma unroll
                    for (int dt = 0; dt < 4; ++dt) { const int kc = kc0 + 16 * t1 + 4 * g4 + ((lane & 15) >> 2), p = lane & 3; voff[t1][dt] = kc * 128 + (((2 * dt + (p >> 1)) ^ (kc & 7)) * 16) + 8 * (p & 1); }
                const int st_key = tid >> 3, st_off = st_key * 128 + (((tid & 7) ^ (st_key & 7)) * 16);
                v4u kreg[9], vreg[9]; pg8::bf16x8 qf[2]; int qtok = 0;
#define NA_FETCH(UN) do { const int h_ = (UN) & 15, gp_ = (UN) >> 4, sq_ = gp_ / (rows / 2), rp_ = gp_ % (rows / 2), rb_ = min(max(2 * rp_ - NA_KH / 2, 0), rows - NA_KH); \
                    const size_t gb_ = (size_t)(sq_ * seqlen + rb_ * GRID_W) * 1024 + h_ * 64 + (tid & 7) * 8 + (size_t)(tid >> 3) * 1024; \
                    _Pragma("unroll") for (int i = 0; i < 9; ++i) { kreg[i] = *(const GAS v4u*)(Kb + gb_ + (size_t)i * 64 * 1024); vreg[i] = *(const GAS v4u*)(Vb + gb_ + (size_t)i * 64 * 1024); } \
                    qtok = sq_ * seqlen + (2 * rp_ + rr) * GRID_W + qcol; \
                    _Pragma("unroll") for (int ks = 0; ks < 2; ++ks) qf[ks] = *(const GAS pg8::bf16x8*)(Qb + (size_t)qtok * 1024 + h_ * 64 + 32 * ks + 8 * g4); } while (0)
                NA_FETCH(min(bx, NUN - 1));
#pragma unroll 1
                for (int un = bx; un < NUN; un += G) {
                    const int h = un & 15, gp = un >> 4, rp = gp % (rows / 2);
                    const int r = 2 * rp + rr, rbase = min(max(2 * rp - NA_KH / 2, 0), rows - NA_KH), r0 = min(max(r - NA_KH / 2, 0), rows - NA_KH), jo = r0 - rbase;
#pragma unroll
                    for (int i = 0; i < 9; ++i) { *(LAS v4u*)(Ks + i * 8192 + st_off) = kreg[i]; *(LAS v4u*)(Vs + i * 8192 + st_off) = vreg[i]; }
                    const pg8::bf16x8 qc0 = qf[0], qc1 = qf[1]; const int qtok_c = qtok;
                    __syncthreads();
                    NA_FETCH(min(un + G, NUN - 1));
                    const bf16* tb = tbl + (size_t)((h * 15 + (r0 - r + NA_KH - 1)) * 4 + jq) * 2 * 256 + lane * 4;
                    v2u bt[16];
#pragma unroll
                    for (int jr = 0; jr < 8; ++jr)
#pragma unroll
                        for (int ch = 0; ch < 2; ++ch) bt[jr * 2 + ch] = *(const GAS v2u*)(tb + (size_t)jr * (4 * 2 * 256) + ch * 256);
                    f32x4 s[16];
                    const LAS unsigned char* kb = Ks + jo * 8192; const LAS unsigned char* vb = Vs + jo * 8192;
#pragma unroll
                    for (int jr = 0; jr < 8; ++jr)
#pragma unroll
                        for (int ch = 0; ch < 2; ++ch) {
                            const pg8::bf16x8 a0 = *(const LAS pg8::bf16x8*)(kb + jr * 8192 + koff[ch][0]), a1 = *(const LAS pg8::bf16x8*)(kb + jr * 8192 + koff[ch][1]);
                            f32x4 z = (f32x4){0.f, 0.f, 0.f, 0.f};
                            z = __builtin_amdgcn_mfma_f32_16x16x32_bf16(a0, qc0, z, 0, 0, 0);
                            s[jr * 2 + ch] = __builtin_amdgcn_mfma_f32_16x16x32_bf16(a1, qc1, z, 0, 0, 0); }
                    float mx = -1.0e30f;
#pragma unroll
                    for (int t = 0; t < 16; ++t) { s[t][0] += bflo(bt[t].x); s[t][1] += bfhi(bt[t].x); s[t][2] += bflo(bt[t].y); s[t][3] += bfhi(bt[t].y);
                        mx = fmaxf(mx, fmaxf(fmaxf(s[t][0], s[t][1]), fmaxf(s[t][2], s[t][3]))); }
                    mx = fmaxf(mx, __shfl_xor(mx, 16)); mx = fmaxf(mx, __shfl_xor(mx, 32));
                    const float mxl = mx * 1.4426950408889634f;
                    float sum = 0.f;
#pragma unroll
                    for (int t = 0; t < 16; ++t)
#pragma unroll
                        for (int i = 0; i < 4; ++i) { const float p = __builtin_amdgcn_exp2f(s[t][i] * 1.4426950408889634f - mxl); s[t][i] = p; sum += p; }
                    sum += __shfl_xor(sum, 16); sum += __shfl_xor(sum, 32);
                    const float inv = 1.0f / sum;
                    f32x4 o[4];
#pragma unroll
                    for (int dt = 0; dt < 4; ++dt) o[dt] = (f32x4){0.f, 0.f, 0.f, 0.f};
#pragma unroll
                    for (int jr = 0; jr < 8; ++jr) {
                        pg8::u32x4 pw; pw.x = pg8::cvt_pk_bf16(s[2 * jr][0], s[2 * jr][1]); pw.y = pg8::cvt_pk_bf16(s[2 * jr][2], s[2 * jr][3]);
                        pw.z = pg8::cvt_pk_bf16(s[2 * jr + 1][0], s[2 * jr + 1][1]); pw.w = pg8::cvt_pk_bf16(s[2 * jr + 1][2], s[2 * jr + 1][3]);
                        const pg8::bf16x8 pf = __builtin_bit_cast(pg8::bf16x8, pw);
#pragma unroll
                        for (int dt = 0; dt < 4; ++dt) {
                            typedef short v4s __attribute__((ext_vector_type(4)));
                            const v4s t0 = __builtin_amdgcn_ds_read_tr16_b64_v4i16((LAS v4s*)(vb + jr * 8192 + voff[0][dt])), t1 = __builtin_amdgcn_ds_read_tr16_b64_v4i16((LAS v4s*)(vb + jr * 8192 + voff[1][dt]));
                            const pg8::bf16x8 vf = __builtin_shufflevector(t0, t1, 0, 1, 2, 3, 4, 5, 6, 7);
                            o[dt] = __builtin_amdgcn_mfma_f32_16x16x32_bf16(vf, pf, o[dt], 0, 0, 0); }
                    }
#pragma unroll
                    for (int dt = 0; dt < 4; ++dt) { v2u ov; ov.x = pk2(o[dt][0] * inv, o[dt][1] * inv); ov.y = pk2(o[dt][2] * inv, o[dt][3] * inv);
                        *(GAS v2u*)(PC + (size_t)qtok_c * 1024 + h * 64 + 16 * dt + 4 * g4) = ov; }
                    __syncthreads();
                }
#undef NA_FETCH
            }
            GRID_BAR();
            {
                pg8::Gemm g{WSP(bf16, WS_P3), WSP(bf16, WS_WBR) + (size_t)l * 3 * DM * 1024, 1024, 1024, 1024, 0, ZSTRIDE * 2, (size_t)DM * 1024 * 2}; pg8::TripleOrder S; S.init(CH, DM, G, bx, 4);
                pg8::EpiGate E{WSP(bf16, WS_G), WSP(bf16, WS_MERGED)};
                pg8::gemm_phase<pg8::EpiGate, pg8::TripleOrder, PG8_ALIGN, PG8_SP2>(lds + RING_OFF, g, S, E);
            }
            GRID_BAR();
            {
                pg8::Gemm g{WSP(bf16, WS_MERGED), WSP(bf16, WS_WOUT) + (size_t)l * DM * DM, DM, DM, DM, 0, 0, 0}; pg8::StaticOrder S; S.init(CH, DM, G, bx, 4);
                float* st = WSP(float, WS_STATS);
                pg8::EpiResLn E{l == 0 ? chunk_x0(c) : (const float*)nullptr, (float*)nullptr, WSP(bf16, WS_RF), WSP(bf16, WS_XB), l ? st + 1 * CH * 2 : (const float*)nullptr, arg_in(I_LN2G), arg_in(I_LN2B), st + (l ? 2 : 0) * CH * 2};
                pg8::gemm_phase<pg8::EpiResLn, pg8::StaticOrder, PG8_ALIGN, PG8_SP2>(lds + RING_OFF, g, S, E);
            }
            GRID_BAR();
            {
                pg8::Gemm g{WSP(bf16, WS_XB), WSP(bf16, WS_WUP) + (size_t)l * DFF * DM, DM, DM, DM, 0, 0, 0}; pg8::StaticOrder S; S.init(CH, DFF, G, bx);
                const float* cs = WSP(float, WS_CTL + CS_OFF);
                pg8::EpiSq E{WSP(bf16, WS_H), pg8::LnFold{WSP(float, WS_STATS) + (l ? 2 : 0) * CH * 2, cs + CS_WUP_G + l * DFF, cs + CS_WUP_B + l * DFF}};
                pg8::gemm_phase<pg8::EpiSq, pg8::StaticOrder, PG8_ALIGN, PG8_SP2>(lds + RING_OFF, g, S, E);
            }
            GRID_BAR();
            {
                pg8::Gemm g{WSP(bf16, WS_H), WSP(bf16, WS_WDN) + (size_t)l * DM * DFF, DFF, DFF, DFF, 0, 0, 0}; pg8::StaticOrder S; S.init(CH, DM, G, bx, 4);
                float* st = WSP(float, WS_STATS);
                pg8::EpiResLn E{(const float*)nullptr, l == 0 ? (float*)nullptr : chunk_R(c), WSP(bf16, WS_RF), WSP(bf16, WS_XB), st + (l ? 2 : 0) * CH * 2, arg_in(I_LN1G) + l * DM, arg_in(I_LN1B) + l * DM, l == 0 ? st + 1 * CH * 2 : (float*)nullptr};
                pg8::gemm_phase<pg8::EpiResLn, pg8::StaticOrder, PG8_ALIGN, PG8_SP2>(lds + RING_OFF, g, S, E);
            }
            GRID_BAR();
        }
        {
            FRESH_TID();
            float* R = chunk_R(c); const float* lg = arg_in(I_LN2G) + (DEPTH - 1) * DM; const float* lb = arg_in(I_LN2B) + (DEPTH - 1) * DM;
            for (int m = gw; m < CH; m += NGW) ln_row(R + (size_t)m * DM, (bf16*)nullptr, lg, lb, lane);
        }
    }
#undef GRID_BAR
}

extern "C" void kernel_launch(void* const* d_in, const int* in_sizes, int n_in, void* d_out, int out_size, void* d_ws, size_t ws_size, hipStream_t stream) {
    static int grid = 0;
    if (grid == 0) {
        if (n_in != 20 || out_size != NTOK * DM || ws_size < WS_END) { fprintf(stderr, "kernel_launch: unexpected problem (n_in %d, out %d, ws %zu); nothing launched\n", n_in, out_size, ws_size); grid = -1; return; }
        int dev = 0, cus = 0, per_cu = 0;
        if (hipGetDevice(&dev) != hipSuccess || hipDeviceGetAttribute(&cus, hipDeviceAttributeMultiprocessorCount, dev) != hipSuccess) { grid = -1; return; }
        if (hipFuncSetAttribute((const void*)fwd_kernel, hipFuncAttributeMaxDynamicSharedMemorySize, LDS_BYTES) != hipSuccess) { fprintf(stderr, "kernel_launch: hipFuncSetAttribute failed\n"); grid = -1; return; }
        if (hipOccupancyMaxActiveBlocksPerMultiprocessor(&per_cu, (const void*)fwd_kernel, 512, LDS_BYTES) != hipSuccess || per_cu < 1) { fprintf(stderr, "kernel_launch: occupancy query says %d blocks per CU\n", per_cu); }
        (void)hipGetLastError();
        grid = cus;
    }
    if (grid < 0) return;
    if (hipMemsetAsync((char*)d_ws + WS_CTL, 0, CTL_ZERO_BYTES, stream) != hipSuccess) return;
    Args a{};
    for (int i = 0; i < 20; ++i) a.in[i] = (const float*)d_in[i];
    a.out = (float*)d_out; a.ws = (unsigned char*)d_ws;
    hipLaunchKernelGGL(fwd_kernel, dim3(grid), dim3(512), LDS_BYTES, stream, a);
}
```
